# Optimizing an MI355X kernel written in HIP

```python
import jax, jax.numpy as jnp
from jax import lax
import numpy as np

D_MODEL = 1024
BATCH = 8
SEQ = 8192
DEPTH = 4

PLE_DIM = 256
D_FF = 2816
Q_BLOCK = 128
HGRN_CHUNK = 32
EPS = 1e-6
N_BRANCH = 4
FOX_HEADS = 4
FOX_DIM = 64
FOX_W = FOX_HEADS * FOX_DIM
MLA_HEADS = 4
MLA_NOPE = 64
MLA_ROPE = 32
MLA_V = 64
MLA_Q_RANK = 256
MLA_KV_RANK = 128
MLA_W = MLA_HEADS * MLA_V
ROPE_BASE = 10000.0
SB_HEADS = 4
SB_DIM = 64
SB_W = SB_HEADS * SB_DIM
HG_HEADS = 4
HG_DK = 64
HG_DV = 64
HG_W = HG_HEADS * HG_DK
BRANCH_W = 256
IN_SPLITS = (FOX_W, FOX_W, FOX_W, FOX_HEADS,
             MLA_Q_RANK, MLA_KV_RANK, MLA_ROPE,
             SB_W, SB_W, SB_W,
             HG_W, HG_W, HG_W, HG_W,
             N_BRANCH * D_MODEL)
IN_COLS = sum(IN_SPLITS)

kernel_name = "hybrid_fox_mla_stickbreak_hgrn2_macaron"

F32 = jnp.float32


def rmsnorm(x, g):
    xf = x.astype(F32)
    y = xf * lax.rsqrt(jnp.mean(xf * xf, axis=-1, keepdims=True) + EPS)
    return (y * g.astype(F32)).astype(x.dtype)


def heads(t, h):
    b, s, _ = t.shape
    return t.reshape(b, s, h, -1).transpose(0, 2, 1, 3)


def merge_heads(t):
    b, h, s, d = t.shape
    return t.transpose(0, 2, 1, 3).reshape(b, s, h * d)


def block_cumsum(x, blk):
    *lead, n = x.shape
    nb = n // blk
    xb = x.reshape(*lead, nb, blk)
    within = jnp.einsum('...ks,ts->...kt', xb, jnp.tril(jnp.ones((blk, blk), x.dtype)))
    prev = jnp.einsum('...k,jk->...j', within[..., -1], jnp.tril(jnp.ones((nb, nb), x.dtype), -1))
    return (within + prev[..., None]).reshape(*lead, n)


def suffix_sum_exclusive(x, blk):
    *lead, n = x.shape
    nb = n // blk
    xb = x.reshape(*lead, nb, blk)
    within = jnp.einsum('...ks,ts->...kt', xb, jnp.triu(jnp.ones((blk, blk), x.dtype), 1))
    later = jnp.einsum('...k,jk->...j', jnp.sum(xb, axis=-1), jnp.triu(jnp.ones((nb, nb), x.dtype), 1))
    return (within + later[..., None]).reshape(*lead, n)


def rotary(x, pos):
    half = x.shape[-1] // 2
    inv = ROPE_BASE ** (-jnp.arange(half, dtype=F32) / half)
    ang = pos.astype(F32)[:, None] * inv[None, :]
    cos, sin = jnp.cos(ang).astype(x.dtype), jnp.sin(ang).astype(x.dtype)
    x1, x2 = x[..., :half], x[..., half:]
    return jnp.concatenate([x1 * cos - x2 * sin, x2 * cos + x1 * sin], axis=-1)


def swiglu(h, wi, wo):
    g, u = jnp.split(h @ wi, 2, axis=-1)
    return (jax.nn.silu(g) * u) @ wo


def causal_softmax_attention(q, k, v, scale, decay=None):
    s_len = q.shape[2]
    q = q * scale
    outs = []
    for i in range(s_len // Q_BLOCK):
        lo, hi = i * Q_BLOCK, (i + 1) * Q_BLOCK
        s = jnp.einsum('bhqd,bhkd->bhqk', q[:, :, lo:hi], k[:, :, :hi], preferred_element_type=F32)
        if decay is not None:
            s = s + decay[:, :, lo:hi, None] - decay[:, :, None, :hi]
        allowed = jnp.arange(hi)[None, :] <= (lo + jnp.arange(Q_BLOCK))[:, None]
        s = jnp.where(allowed, s, -jnp.inf)
        e = jnp.exp(s - jnp.max(s, axis=-1, keepdims=True))
        o = jnp.einsum('bhqk,bhkd->bhqd', e.astype(v.dtype), v[:, :, :hi], preferred_element_type=F32)
        outs.append((o / jnp.sum(e, axis=-1, keepdims=True)).astype(v.dtype))
    return jnp.concatenate(outs, axis=2)


def stick_breaking_attention(q, k, v, scale):
    s_len = q.shape[2]
    q = q * scale
    outs = []
    for i in range(s_len // Q_BLOCK):
        lo, hi = i * Q_BLOCK, (i + 1) * Q_BLOCK
        z = jnp.einsum('bhqd,bhkd->bhqk', q[:, :, lo:hi], k[:, :, :hi], preferred_element_type=F32)
        strict = jnp.arange(hi)[None, :] < (lo + jnp.arange(Q_BLOCK))[:, None]
        log_beta = jax.nn.log_sigmoid(z)
        log_rest = jnp.where(strict, log_beta - z, 0.0)
        later = suffix_sum_exclusive(log_rest, Q_BLOCK)
        a = jnp.where(strict, jnp.exp(log_beta + later), 0.0)
        outs.append(jnp.einsum('bhqk,bhkd->bhqd', a.astype(v.dtype), v[:, :, :hi]))
    return jnp.concatenate(outs, axis=2)


def hgrn2_chunkwise(q, k, v, log_f):
    b, h, s_len, dk = q.shape
    dv = v.shape[-1]
    c = HGRN_CHUNK
    n = s_len // c

    def chunks(t):
        return jnp.moveaxis(t.astype(F32).reshape(b, h, n, c, t.shape[-1]), 2, 0)

    tril = jnp.tril(jnp.ones((c, c), F32))
    cum = jnp.einsum('nbhsd,ts->nbhtd', chunks(log_f), tril)
    causal = jnp.tril(jnp.ones((c, c), dtype=bool))[:, :, None]

    def step(state, args):
        qc, kc, vc, bc = args
        diff = bc[:, :, :, None, :] - bc[:, :, None, :, :]
        dec = jnp.exp(jnp.where(causal, diff, -jnp.inf))
        scores = jnp.einsum('bhtsd,bhsd->bhts', qc[:, :, :, None, :] * dec, kc)
        o = jnp.einsum('bhts,bhsv->bhtv', scores, vc)
        o = o + jnp.einsum('bhtd,bhdv->bhtv', qc * jnp.exp(bc), state)
        b_last = bc[:, :, -1, :]
        k_dec = kc * jnp.exp(b_last[:, :, None, :] - bc)
        new_state = state * jnp.exp(b_last)[..., None] + jnp.einsum('bhsd,bhsv->bhdv', k_dec, vc)
        return new_state, o

    state0 = jnp.zeros((b, h, dk, dv), F32)
    _, o = lax.scan(step, state0, (chunks(q), chunks(k), chunks(v), cum))
    return jnp.moveaxis(o, 0, 2).reshape(b, h, s_len, dv)


def token_mixing(h, lb, w_in, b_f, q_norm, w_uq, kv_norm, w_ukv, out_norm, w_branch, w_out, pos):
    bsz, s_len, _ = h.shape
    offsets = [int(o) for o in np.cumsum(IN_SPLITS)[:-1]]
    (fq, fk, fv, ff, mcq, mckv, mkr, sq, sk, sv, hq, hf, hi, hg, gates) = jnp.split(h @ w_in, offsets, axis=-1)

    log_f = jax.nn.log_sigmoid((ff + b_f).astype(F32))
    decay = block_cumsum(log_f.transpose(0, 2, 1), Q_BLOCK)
    y_a = causal_softmax_attention(heads(fq, FOX_HEADS), heads(fk, FOX_HEADS), heads(fv, FOX_HEADS),
                                   FOX_DIM ** -0.5, decay)

    qm = heads(rmsnorm(mcq, q_norm) @ w_uq, MLA_HEADS)
    kvm = heads(rmsnorm(mckv, kv_norm) @ w_ukv, MLA_HEADS)
    q_b = jnp.concatenate([qm[..., :MLA_NOPE], rotary(qm[..., MLA_NOPE:], pos)], axis=-1)
    k_rope = jnp.broadcast_to(rotary(mkr[:, None], pos), (bsz, MLA_HEADS, s_len, MLA_ROPE))
    k_b = jnp.concatenate([kvm[..., :MLA_NOPE], k_rope], axis=-1)
    y_b = causal_softmax_attention(q_b, k_b, kvm[..., MLA_NOPE:], (MLA_NOPE + MLA_ROPE) ** -0.5)

    y_c = stick_breaking_attention(heads(sq, SB_HEADS), heads(sk, SB_HEADS), heads(sv, SB_HEADS), SB_DIM ** -0.5)

    f = lb + (1.0 - lb) * jax.nn.sigmoid(hf.astype(F32))
    o_d = hgrn2_chunkwise(heads(hq, HG_HEADS), heads(1.0 - f, HG_HEADS), heads(hi, HG_HEADS),
                          heads(jnp.log(f), HG_HEADS)).astype(h.dtype)
    o_d = rmsnorm(o_d, out_norm.reshape(HG_HEADS, 1, HG_DV))
    y_d = merge_heads(o_d) * jax.nn.silu(hg)

    ys = jnp.stack([merge_heads(y_a), merge_heads(y_b), merge_heads(y_c), y_d], axis=2)
    proj = jnp.einsum('bsnc,ncd->bsnd', ys, w_branch)
    g = jax.nn.sigmoid(gates).reshape(bsz, s_len, N_BRANCH, D_MODEL)
    return jnp.sum(g * proj, axis=2) @ w_out


def setup_inputs(seed: int = 0) -> dict:
    key = jax.random.key(seed)
    ks = jax.random.split(key, 24)
    nrm = lambda k, shape, s: jax.random.normal(k, shape, F32) * s
    gain = lambda k, shape: 1.0 + 0.05 * jax.random.normal(k, shape, F32)
    return {
        "x": nrm(ks[0], (BATCH, SEQ, D_MODEL), 1.0),
        "p": nrm(ks[1], (DEPTH, BATCH, SEQ, PLE_DIM), 1.0),
        "w_in": nrm(ks[2], (DEPTH, D_MODEL, IN_COLS), D_MODEL ** -0.5),
        "b_fox_f": 3.0 + nrm(ks[3], (DEPTH, FOX_HEADS), 0.5),
        "mla_q_norm": gain(ks[4], (DEPTH, MLA_Q_RANK)),
        "w_mla_uq": nrm(ks[5], (DEPTH, MLA_Q_RANK, MLA_HEADS * (MLA_NOPE + MLA_ROPE)), MLA_Q_RANK ** -0.5),
        "mla_kv_norm": gain(ks[6], (DEPTH, MLA_KV_RANK)),
        "w_mla_ukv": nrm(ks[7], (DEPTH, MLA_KV_RANK, MLA_HEADS * (MLA_NOPE + MLA_V)), MLA_KV_RANK ** -0.5),
        "hgrn_lb_logits": nrm(ks[8], (DEPTH, HG_W), 0.1),
        "hgrn_out_norm": gain(ks[9], (DEPTH, HG_W)),
        "w_branch": nrm(ks[10], (DEPTH, N_BRANCH, BRANCH_W, D_MODEL), BRANCH_W ** -0.5),
        "w_out": nrm(ks[11], (DEPTH, D_MODEL, D_MODEL), 0.5 * D_MODEL ** -0.5),
        "ffn_a_wi": nrm(ks[12], (DEPTH, D_MODEL, 2 * D_FF), D_MODEL ** -0.5),
        "ffn_a_wo": nrm(ks[13], (DEPTH, D_FF, D_MODEL), D_FF ** -0.5),
        "ffn_b_wi": nrm(ks[14], (DEPTH, D_MODEL, 2 * D_FF), D_MODEL ** -0.5),
        "ffn_b_wo": nrm(ks[15], (DEPTH, D_FF, D_MODEL), D_FF ** -0.5),
        "w_ple_in": nrm(ks[16], (DEPTH, PLE_DIM, D_MODEL), 0.5 * PLE_DIM ** -0.5),
        "w_ple_gate": nrm(ks[17], (DEPTH, D_MODEL, D_MODEL), D_MODEL ** -0.5),
        "norms": gain(ks[18], (DEPTH, 4, D_MODEL)),
        "final_norm": gain(ks[19], (D_MODEL,)),
    }


def reference(x, p, w_in, b_fox_f, mla_q_norm, w_mla_uq, mla_kv_norm, w_mla_ukv, hgrn_lb_logits,
              hgrn_out_norm, w_branch, w_out, ffn_a_wi, ffn_a_wo, ffn_b_wi, ffn_b_wo,
              w_ple_in, w_ple_gate, norms, final_norm):
    pos = jnp.arange(x.shape[1])
    lb_soft = jax.nn.softmax(hgrn_lb_logits.astype(F32), axis=0)
    lb_cum = jnp.cumsum(lb_soft, axis=0)
    lower_bounds = lb_cum - lb_cum[0]
    for i in range(DEPTH):
        x = x + 0.5 * swiglu(rmsnorm(x, norms[i, 0]), ffn_a_wi[i], ffn_a_wo[i])
        x = x + token_mixing(rmsnorm(x, norms[i, 1]), lower_bounds[i], w_in[i], b_fox_f[i],
                             mla_q_norm[i], w_mla_uq[i], mla_kv_norm[i], w_mla_ukv[i],
                             hgrn_out_norm[i], w_branch[i], w_out[i], pos)
        x = x + 0.5 * swiglu(rmsnorm(x, norms[i, 2]), ffn_b_wi[i], ffn_b_wo[i])
        x = x + jax.nn.sigmoid(rmsnorm(x, norms[i, 3]) @ w_ple_gate[i]) * (p[i] @ w_ple_in[i])
    return rmsnorm(x, final_norm)
```

```cpp
#include <hip/hip_runtime.h>
#include <hip/hip_bf16.h>
#include <cstdio>
#include <cstdint>
#include <cmath>

#define LAS __attribute__((address_space(3)))
#define GAS __attribute__((address_space(1)))
typedef unsigned short bf16_t;
typedef short bf16x8 __attribute__((ext_vector_type(8)));
typedef short s16x4 __attribute__((ext_vector_type(4)));
typedef float f32x4 __attribute__((ext_vector_type(4)));
typedef float f32x2 __attribute__((ext_vector_type(2)));
typedef float f32x16 __attribute__((ext_vector_type(16)));
typedef unsigned u32x4 __attribute__((ext_vector_type(4)));
typedef unsigned u32x2 __attribute__((ext_vector_type(2)));

constexpr int NTOK = 65536, DM = 1024, SEQ = 8192, NBATCH = 8, DEPTH = 4, FF = 2816, PLE = 256;
constexpr int NMIX = 3072, NGATE = 4096, INCOLS = 7076;
constexpr float EPS = 1e-6f, LOG2E = 1.4426950408889634f, LN2 = 0.6931471805599453f;
constexpr int MX_FQ = 0, MX_FK = 256, MX_FV = 512, MX_MCQ = 768, MX_T4 = 1024, MX_SQ = 1280, MX_SK = 1536, MX_SV = 1792, MX_HQ = 2048, MX_HF = 2304, MX_HI = 2560, MX_HG = 2816;

__device__ __forceinline__ unsigned cvt_pk_bf16(float lo, float hi) { typedef __bf16 bf16x2_t __attribute__((ext_vector_type(2))); f32x2 v = {lo, hi}; bf16x2_t b = __builtin_convertvector(v, bf16x2_t); return __builtin_bit_cast(unsigned, b); }
__device__ __forceinline__ unsigned cvt_pk_bf16_v(float lo, float hi) { unsigned r; asm volatile("v_cvt_pk_bf16_f32 %0, %1, %2" : "=v"(r) : "v"(lo), "v"(hi)); return r; }
__device__ __forceinline__ float bf_lo(unsigned w) { return __uint_as_float(w << 16); }
__device__ __forceinline__ float bf_hi(unsigned w) { return __uint_as_float(w & 0xffff0000u); }
__device__ __forceinline__ float fast_exp2(float x) { return __builtin_amdgcn_exp2f(x); }
__device__ __forceinline__ float fast_log2(float x) { return __builtin_amdgcn_logf(x); }
__device__ __forceinline__ float fast_rcp(float x) { return __builtin_amdgcn_rcpf(x); }
__device__ __forceinline__ float sigmoidf_(float x) { return fast_rcp(1.f + fast_exp2(-x * LOG2E)); }
__device__ __forceinline__ float rstd16(const float* ps, int row) { const f32x4* p = (const f32x4*)(ps + (size_t)row * 16); const f32x4 a = p[0], b = p[1], c = p[2], d = p[3];
    const f32x4 t = (a + b) + (c + d); return __builtin_amdgcn_rsqf(((t[0] + t[1]) + (t[2] + t[3])) * (1.f / 1024.f) + 1e-6f); }
__device__ __forceinline__ float rstd4(const float* ps, int row, float inv_n) { const f32x4 t = *(const f32x4*)(ps + (size_t)row * 4); return __builtin_amdgcn_rsqf(((t[0] + t[1]) + (t[2] + t[3])) * inv_n + 1e-6f); }
__device__ __forceinline__ float rstd_from(float sumsq, float inv_n) { return __builtin_amdgcn_rsqf(sumsq * inv_n + EPS); }

namespace pg8 {
constexpr int BM = 256, BK = 64, HALF = 128, HTB = HALF * BK * 2  , STAGE_BYTES = 8 * HTB, NXCD = 8, WGM = 8;
__host__ __device__ __forceinline__ int lds_byte(int r, int c) { const int st = (r >> 4) * 2 + (c >> 5), rr = r & 15, cc = c & 31, ob = rr * 64 + cc * 2; return st * 1024 + (ob ^ (((ob >> 9) & 1) << 5)); }
__host__ __device__ __forceinline__ void stage_rc(int b, int& R, int& C) { const int st = b / 1024, sb = b % 1024, swz = sb ^ (((sb >> 9) & 1) << 5); R = (st >> 1) * 16 + swz / 64; C = (st & 1) * 32 + (swz % 64) / 2; }
__host__ __device__ __forceinline__ int perm32(int rho) { const int n = rho >> 4, i = rho & 15; return 8 * (i >> 2) + 4 * n + (i & 3); }

struct Unit { int pm, pn; };
struct Gemm { const bf16_t* A; const bf16_t* Bt; int M, N, K, lda, ldb, a_shift, a_goff; };

struct StaticOrder {
    int nM, nN, nwg, G, c;
    __host__ __device__ void init(int M, int N, int G_, int c_) { nM = M / BM; nN = N / BM; nwg = nM * nN; G = G_; c = c_; }
    __host__ __device__ bool next(int i, Unit& u) const {
        const long L = (long)i * G + c; if (L >= nwg) return false;
        int wgid = (int)L; { const int q = nwg / NXCD, r = nwg % NXCD, xcd = wgid % NXCD, off = wgid / NXCD; wgid = (xcd < r ? xcd * (q + 1) : r * (q + 1) + (xcd - r) * q) + off; }
        const int nig = WGM * nN, gid = wgid / nig, fm = gid * WGM, gsz = (nM - fm) < WGM ? (nM - fm) : WGM;
        u.pm = fm + ((wgid % nig) % gsz); u.pn = (wgid % nig) / gsz; return true;
    }
};

template <class Epi>
__device__ __forceinline__ void gemm_phase(LAS unsigned char* lds, const Gemm g, const StaticOrder& S, const Epi& E) {
    int tid_ = threadIdx.x; asm volatile("" : "+v"(tid_));
    const int tid = tid_, wid = __builtin_amdgcn_readfirstlane(tid >> 6), lane = tid & 63, wr = wid >> 2, wc = wid & 3, fr = lane & 15, fq = lane >> 4;
    const int K = g.K, nt = K / BK;
    unsigned voffA[2], voffB[2];
#pragma unroll
    for (int i = 0; i < 2; ++i) { int R, C; stage_rc(tid * 16 + i * 8192, R, C); const int Rb = Epi::PERM ? ((R & ~31) + perm32(R & 31)) : R;
        voffA[i] = (unsigned)(R * g.lda + C) * 2u; voffB[i] = (unsigned)(Rb * g.ldb + C) * 2u; }
    const size_t kstep = (size_t)(BK * 2);
    const size_t hstepA = (size_t)HALF * g.lda * 2, hstepB = (size_t)HALF * g.ldb * 2;
    const size_t tstepA = 2 * hstepA, tstepB = 2 * hstepB;
    const unsigned ldsw = (unsigned)wid * 1024u;
    const int aoff = lds_byte(wr * 64 + fr, fq * 8), boff = lds_byte(wc * 32 + fr, fq * 8);
#define PG8_SA(b, h) (((b) * 2 + (h)) * HTB)
#define PG8_SB(b, h) ((4 + (b) * 2 + (h)) * HTB)
#define PG8_STAGE(bufoff, gbase, voff) do { _Pragma("unroll") for (int _i = 0; _i < 2; ++_i) \
        __builtin_amdgcn_global_load_lds((const unsigned*)((const char*)(gbase) + (voff)[_i]), (LAS unsigned*)(lds + (bufoff) + ldsw + _i * 8192), 16, 0, 0); } while (0)
#define PG8_LDA(dst, b, h) do { _Pragma("unroll") for (int m = 0; m < 4; ++m) _Pragma("unroll") for (int k = 0; k < 2; ++k) dst[m][k] = *(const LAS bf16x8*)(lds + PG8_SA(b, h) + aoff + m * 2048 + k * 1024); } while (0)
#define PG8_LDB(dst, b, h) do { _Pragma("unroll") for (int n = 0; n < 2; ++n) _Pragma("unroll") for (int k = 0; k < 2; ++k) dst[n][k] = *(const LAS bf16x8*)(lds + PG8_SB(b, h) + boff + n * 2048 + k * 1024); } while (0)
#define PG8_MMA(ai, bj, At, Bt) do { __builtin_amdgcn_s_setprio(1); _Pragma("unroll") for (int m = 0; m < 4; ++m) _Pragma("unroll") for (int n = 0; n < 2; ++n) _Pragma("unroll") for (int k = 0; k < 2; ++k) \
        acc[ai][bj][m][n] = __builtin_amdgcn_mfma_f32_16x16x32_bf16(Bt[n][k], At[m][k], acc[ai][bj][m][n], 0, 0, 0); __builtin_amdgcn_s_setprio(0); } while (0)
#define PG8_WAIT_V(n) asm volatile("s_waitcnt vmcnt(" #n ")" ::: "memory")
#define PG8_WAIT_L(n) asm volatile("s_waitcnt lgkmcnt(" #n ")" ::: "memory")
#define PG8_BAR __builtin_amdgcn_s_barrier()
#define PG8_SCHED __builtin_amdgcn_sched_barrier(0)
    Unit cur, nxt; int ui = 0;
    if (!S.next(0, cur)) return;
    f32x4 acc[2][2][4][2];
#pragma unroll
    for (int a = 0; a < 2; ++a)
#pragma unroll
        for (int b = 0; b < 2; ++b)
#pragma unroll
            for (int m = 0; m < 4; ++m)
#pragma unroll
                for (int n = 0; n < 2; ++n) acc[a][b][m][n] = (f32x4){0.f, 0.f, 0.f, 0.f};
    bf16x8 At[4][2], B0[2][2], B1[2][2];
    const char* cA = (const char*)g.A + (size_t)cur.pm * tstepA + (size_t)((cur.pn >> g.a_shift) * g.a_goff) * 2; const char* cB = (const char*)g.Bt + (size_t)cur.pn * tstepB;
    PG8_STAGE(PG8_SB(0, 0), cB, voffB); PG8_STAGE(PG8_SB(0, 1), cB + hstepB, voffB); PG8_STAGE(PG8_SA(0, 0), cA, voffA); PG8_STAGE(PG8_SA(0, 1), cA + hstepA, voffA);
    if (wr == 1) PG8_BAR;
    PG8_WAIT_V(2); PG8_BAR;
    PG8_STAGE(PG8_SB(1, 0), cB + kstep, voffB); PG8_STAGE(PG8_SA(1, 0), cA + kstep, voffA); PG8_STAGE(PG8_SB(1, 1), cB + hstepB + kstep, voffB);
    PG8_WAIT_V(6); PG8_BAR;
    for (;;) {
        const bool has_next = S.next(ui + 1, nxt);
        const char* nA = has_next ? (const char*)g.A + (size_t)nxt.pm * tstepA + (size_t)((nxt.pn >> g.a_shift) * g.a_goff) * 2 : cA; const char* nB = has_next ? (const char*)g.Bt + (size_t)nxt.pn * tstepB : cB;
#pragma unroll 1
        for (int t = 0; t < nt; t += 2) {
            const bool last = (t == nt - 2);
            const char* a1 = cA + (size_t)(t + 1) * kstep;
            const char* a2 = last ? nA : cA + (size_t)(t + 2) * kstep; const char* b2 = last ? nB : cB + (size_t)(t + 2) * kstep;
            const char* a3 = a2 + kstep; const char* b3 = b2 + kstep;
            PG8_LDB(B0, 0, 0); PG8_LDB(B1, 0, 1); PG8_SCHED; PG8_LDA(At, 0, 0); PG8_STAGE(PG8_SA(1, 1), a1 + hstepA, voffA);
            PG8_WAIT_V(8); PG8_WAIT_L(0); PG8_BAR; PG8_MMA(0, 0, At, B0); PG8_MMA(0, 1, At, B1); PG8_BAR; PG8_SCHED;
            PG8_LDA(At, 0, 1); PG8_STAGE(PG8_SB(0, 0), b2, voffB); PG8_STAGE(PG8_SB(0, 1), b2 + hstepB, voffB); PG8_STAGE(PG8_SA(0, 0), a2, voffA);
            PG8_WAIT_V(8); PG8_WAIT_L(0); PG8_BAR; PG8_MMA(1, 0, At, B0); PG8_MMA(1, 1, At, B1); PG8_BAR; PG8_SCHED;
            PG8_LDB(B0, 1, 0); PG8_LDB(B1, 1, 1); PG8_SCHED; PG8_LDA(At, 1, 0); PG8_STAGE(PG8_SA(0, 1), a2 + hstepA, voffA);
            PG8_WAIT_V(8); PG8_WAIT_L(0); PG8_BAR; PG8_MMA(0, 0, At, B0); PG8_MMA(0, 1, At, B1); PG8_BAR; PG8_SCHED;
            PG8_LDA(At, 1, 1); PG8_STAGE(PG8_SB(1, 0), b3, voffB); PG8_STAGE(PG8_SB(1, 1), b3 + hstepB, voffB); PG8_STAGE(PG8_SA(1, 0), a3, voffA);
            PG8_WAIT_V(8); PG8_WAIT_L(0); PG8_BAR; PG8_MMA(1, 0, At, B0); PG8_MMA(1, 1, At, B1); PG8_BAR; PG8_SCHED;
        }
        if (wr == 0) PG8_BAR;
        E(acc, cur, wr, wc, fr, fq);
        if (!has_next) break;
#pragma unroll
        for (int a = 0; a < 2; ++a)
#pragma unroll
            for (int b = 0; b < 2; ++b)
#pragma unroll
                for (int m = 0; m < 4; ++m)
#pragma unroll
                    for (int n = 0; n < 2; ++n) acc[a][b][m][n] = (f32x4){0.f, 0.f, 0.f, 0.f};
        cur = nxt; cA = nA; cB = nB; ++ui;
        if (wr == 1) PG8_BAR;
    }
    PG8_WAIT_V(0);
    PG8_BAR;
#undef PG8_SA
#undef PG8_SB
#undef PG8_STAGE
#undef PG8_LDA
#undef PG8_LDB
#undef PG8_MMA
#undef PG8_WAIT_V
#undef PG8_WAIT_L
#undef PG8_BAR
#undef PG8_SCHED
}

#define EPI_ARGS const f32x4 (&acc)[2][2][4][2], const Unit& u, int wr, int wc, int fr, int fq
template <int ldc> struct EpiBf16 {
    static constexpr bool PERM = true;
    bf16_t* O;
    __device__ __forceinline__ void operator()(EPI_ARGS) const {
        const int row0 = u.pm * BM + wr * 64 + fr, col0 = u.pn * BM + wc * 32 + 8 * fq;
#pragma unroll
        for (int ai = 0; ai < 2; ++ai)
#pragma unroll
            for (int m = 0; m < 4; ++m) { bf16_t* rowp = O + (size_t)(row0 + ai * HALF + m * 16) * ldc + col0;
#pragma unroll
                for (int bj = 0; bj < 2; ++bj) { const f32x4 v0 = acc[ai][bj][m][0], v1 = acc[ai][bj][m][1];
                    u32x4 w; w.x = cvt_pk_bf16_v(v0[0], v0[1]); w.y = cvt_pk_bf16_v(v0[2], v0[3]); w.z = cvt_pk_bf16_v(v1[0], v1[1]); w.w = cvt_pk_bf16_v(v1[2], v1[3]);
                    *(u32x4*)(rowp + bj * HALF) = w; } }
    }
};
struct EpiSwiglu {
    static constexpr bool PERM = true;
    bf16_t* H; const float* sq;
    __device__ __forceinline__ void operator()(EPI_ARGS) const {
        const int row0 = u.pm * BM + wr * 64 + fr, col0 = u.pn * HALF + wc * 32 + 8 * fq;
#pragma unroll
        for (int ai = 0; ai < 2; ++ai)
#pragma unroll
            for (int m = 0; m < 4; ++m) { const int row = row0 + ai * HALF + m * 16; const float rs = rstd16(sq, row);
                float h[8];
#pragma unroll
                for (int n = 0; n < 2; ++n)
#pragma unroll
                    for (int i = 0; i < 4; ++i) { const float gv = acc[ai][0][m][n][i] * rs, uv = acc[ai][1][m][n][i] * rs; h[4 * n + i] = gv * sigmoidf_(gv) * uv; }
                u32x4 w; w.x = cvt_pk_bf16_v(h[0], h[1]); w.y = cvt_pk_bf16_v(h[2], h[3]); w.z = cvt_pk_bf16_v(h[4], h[5]); w.w = cvt_pk_bf16_v(h[6], h[7]);
                *(u32x4*)(H + (size_t)row * FF + col0) = w; }
    }
};
struct EpiResid {
    static constexpr bool PERM = false;
    const float* base; float* out; bf16_t* xb; float* sq; float alpha;
    __device__ __forceinline__ void operator()(EPI_ARGS) const {
        const int row0 = u.pm * BM + wr * 64 + fr, col0 = u.pn * BM + wc * 32 + 4 * fq;
#pragma unroll
        for (int ai = 0; ai < 2; ++ai)
#pragma unroll
            for (int m = 0; m < 4; ++m) { const int row = row0 + ai * HALF + m * 16; float ss = 0.f;
#pragma unroll
                for (int bj = 0; bj < 2; ++bj)
#pragma unroll
                    for (int n = 0; n < 2; ++n) { const size_t off = (size_t)row * DM + col0 + bj * HALF + n * 16;
                        const f32x4 x = *(const f32x4*)(base + off) + acc[ai][bj][m][n] * alpha;
                        *(f32x4*)(out + off) = x; u32x2 w; w.x = cvt_pk_bf16_v(x[0], x[1]); w.y = cvt_pk_bf16_v(x[2], x[3]); *(u32x2*)(xb + off) = w;
                        ss += (x[0] * x[0] + x[1] * x[1]) + (x[2] * x[2] + x[3] * x[3]); }
                ss += __shfl_xor(ss, 16); ss += __shfl_xor(ss, 32);
                if (fq == 0) sq[(size_t)row * 16 + u.pn * 4 + wc] = ss; }
    }
};
struct EpiPle {
    static constexpr bool PERM = false;
    float* x; bf16_t* xb; const bf16_t* Eb; const float* sq_in; float* sq_out;
    __device__ __forceinline__ void operator()(EPI_ARGS) const {
        const int row0 = u.pm * BM + wr * 64 + fr, col0 = u.pn * BM + wc * 32 + 4 * fq;
#pragma unroll
        for (int ai = 0; ai < 2; ++ai)
#pragma unroll
            for (int m = 0; m < 4; ++m) { const int row = row0 + ai * HALF + m * 16; float ss = 0.f; const float rs = rstd16(sq_in, row);
#pragma unroll
                for (int bj = 0; bj < 2; ++bj)
#pragma unroll
                    for (int n = 0; n < 2; ++n) { const size_t off = (size_t)row * DM + col0 + bj * HALF + n * 16;
                        const u32x2 ev = *(const u32x2*)(Eb + off); const f32x4 a = acc[ai][bj][m][n] * rs;
                        f32x4 xo = *(const f32x4*)(x + off);
                        xo[0] += sigmoidf_(a[0]) * bf_lo(ev.x); xo[1] += sigmoidf_(a[1]) * bf_hi(ev.x); xo[2] += sigmoidf_(a[2]) * bf_lo(ev.y); xo[3] += sigmoidf_(a[3]) * bf_hi(ev.y);
                        *(f32x4*)(x + off) = xo; u32x2 w; w.x = cvt_pk_bf16_v(xo[0], xo[1]); w.y = cvt_pk_bf16_v(xo[2], xo[3]); *(u32x2*)(xb + off) = w;
                        ss += (xo[0] * xo[0] + xo[1] * xo[1]) + (xo[2] * xo[2] + xo[3] * xo[3]); }
                ss += __shfl_xor(ss, 16); ss += __shfl_xor(ss, 32);
                if (fq == 0) sq_out[(size_t)row * 16 + u.pn * 4 + wc] = ss; }
    }
};
struct EpiGate {
    static constexpr bool PERM = false;
    bf16_t* MB; const bf16_t* P; const float* sq;
    __device__ __forceinline__ void operator()(EPI_ARGS) const {
        const int row0 = u.pm * BM + wr * 64 + fr, col0 = u.pn * 64 + wc * 16 + 4 * fq;
#pragma unroll
        for (int ai = 0; ai < 2; ++ai)
#pragma unroll
            for (int m = 0; m < 4; ++m) { const int row = row0 + ai * HALF + m * 16; const float rs = rstd16(sq, row);
                f32x4 s = {0.f, 0.f, 0.f, 0.f};
#pragma unroll
                for (int bj = 0; bj < 2; ++bj)
#pragma unroll
                    for (int n = 0; n < 2; ++n) { const u32x2 pv = *(const u32x2*)(P + (size_t)row * NGATE + (2 * bj + n) * DM + col0); const f32x4 a = acc[ai][bj][m][n] * rs;
                        s[0] += sigmoidf_(a[0]) * bf_lo(pv.x); s[1] += sigmoidf_(a[1]) * bf_hi(pv.x); s[2] += sigmoidf_(a[2]) * bf_lo(pv.y); s[3] += sigmoidf_(a[3]) * bf_hi(pv.y); }
                u32x2 w; w.x = cvt_pk_bf16_v(s[0], s[1]); w.y = cvt_pk_bf16_v(s[2], s[3]); *(u32x2*)(MB + (size_t)row * DM + col0) = w; }
    }
};
struct EpiMix {
    static constexpr bool PERM = false;
    bf16_t* MIX; const float* sq; float* sqq; float* sqkv; bf16_t* KR; float* LF; const float* ropec; const float* ropes; const float* bf;
    __device__ __forceinline__ void operator()(EPI_ARGS) const {
        const int row0 = u.pm * BM + wr * 64 + fr, col0 = u.pn * BM + wc * 32 + 4 * fq;
#pragma unroll
        for (int ai = 0; ai < 2; ++ai)
#pragma unroll
            for (int m = 0; m < 4; ++m) { const int row = row0 + ai * HALF + m * 16; const float rs = rstd16(sq, row);
                f32x4 v[2][2]; float s0 = 0.f, s1 = 0.f;
#pragma unroll
                for (int bj = 0; bj < 2; ++bj)
#pragma unroll
                    for (int n = 0; n < 2; ++n) { const f32x4 a = acc[ai][bj][m][n] * rs; v[bj][n] = a;
                        u32x2 w; w.x = cvt_pk_bf16_v(a[0], a[1]); w.y = cvt_pk_bf16_v(a[2], a[3]); *(u32x2*)(MIX + (size_t)row * NMIX + col0 + bj * HALF + n * 16) = w;
                        const float q = (a[0] * a[0] + a[1] * a[1]) + (a[2] * a[2] + a[3] * a[3]); if (bj == 0) s0 += q; else s1 += q; }
                if (u.pn == 3) { float ss = s0 + s1; ss += __shfl_xor(ss, 16); ss += __shfl_xor(ss, 32); if (fq == 0) sqq[(size_t)row * 4 + wc] = ss; }
                if (u.pn == 4) { float ss = s0; ss += __shfl_xor(ss, 16); ss += __shfl_xor(ss, 32); if (fq == 0) sqkv[(size_t)row * 4 + wc] = ss;
                    if (wc == 0) {
                        const int pos = row & (SEQ - 1); const f32x4 c = *(const f32x4*)(ropec + pos * 16 + 4 * fq), s = *(const f32x4*)(ropes + pos * 16 + 4 * fq);
                        const f32x4 x1 = v[1][0], x2 = v[1][1]; const f32x4 o1 = x1 * c - x2 * s, o2 = x2 * c + x1 * s;
                        u32x2 w1, w2; w1.x = cvt_pk_bf16_v(o1[0], o1[1]); w1.y = cvt_pk_bf16_v(o1[2], o1[3]); w2.x = cvt_pk_bf16_v(o2[0], o2[1]); w2.y = cvt_pk_bf16_v(o2[2], o2[3]);
                        *(u32x2*)(KR + (size_t)row * 32 + 4 * fq) = w1; *(u32x2*)(KR + (size_t)row * 32 + 16 + 4 * fq) = w2; }
                    if (wc == 1 && fq == 0) {
                        f32x4 o;
#pragma unroll
                        for (int i = 0; i < 4; ++i) { const float z = v[1][0][i] + bf[i]; o[i] = -(fmaxf(-z, 0.f) + LN2 * fast_log2(1.f + fast_exp2(-fabsf(z) * LOG2E))); }
                        *(f32x4*)(LF + (size_t)row * 4) = o; } }
            }
    }
};
struct EpiQup {
    static constexpr bool PERM = false;
    bf16_t* QM; const float* sqq; const float* ropec; const float* ropes;
    __device__ __forceinline__ void operator()(EPI_ARGS) const {
        const int row0 = u.pm * BM + wr * 64 + fr;
#pragma unroll
        for (int ai = 0; ai < 2; ++ai)
#pragma unroll
            for (int m = 0; m < 4; ++m) { const int row = row0 + ai * HALF + m * 16; const float rs = rstd4(sqq, row, 1.f / 256.f); bf16_t* qrow = QM + (size_t)row * 384;
                if (u.pn == 0) {
#pragma unroll
                    for (int bj = 0; bj < 2; ++bj)
#pragma unroll
                        for (int n = 0; n < 2; ++n) { const f32x4 a = acc[ai][bj][m][n] * rs; const int head = 2 * bj + (wc >> 1), d = 32 * (wc & 1) + 16 * n + 4 * fq;
                            u32x2 w; w.x = cvt_pk_bf16_v(a[0], a[1]); w.y = cvt_pk_bf16_v(a[2], a[3]); *(u32x2*)(qrow + 96 * head + d) = w; }
                } else {
                    const int pos = row & (SEQ - 1); const f32x4 c = *(const f32x4*)(ropec + pos * 16 + 4 * fq), s = *(const f32x4*)(ropes + pos * 16 + 4 * fq);
                    const f32x4 x1 = acc[ai][0][m][0] * rs, x2 = acc[ai][0][m][1] * rs; const f32x4 o1 = x1 * c - x2 * s, o2 = x2 * c + x1 * s;
                    u32x2 w1, w2; w1.x = cvt_pk_bf16_v(o1[0], o1[1]); w1.y = cvt_pk_bf16_v(o1[2], o1[3]); w2.x = cvt_pk_bf16_v(o2[0], o2[1]); w2.y = cvt_pk_bf16_v(o2[2], o2[3]);
                    *(u32x2*)(qrow + 96 * wc + 64 + 4 * fq) = w1; *(u32x2*)(qrow + 96 * wc + 80 + 4 * fq) = w2; }
                asm volatile("" ::: "memory");
            }
    }
};
struct EpiKVup {
    static constexpr bool PERM = false;
    bf16_t* KN; bf16_t* VM; const float* sqkv;
    __device__ __forceinline__ void operator()(EPI_ARGS) const {
        const int row0 = u.pm * BM + wr * 64 + fr;
#pragma unroll
        for (int ai = 0; ai < 2; ++ai)
#pragma unroll
            for (int m = 0; m < 4; ++m) { const int row = row0 + ai * HALF + m * 16; const float rs = rstd4(sqkv, row, 1.f / 128.f);
#pragma unroll
                for (int bj = 0; bj < 2; ++bj)
#pragma unroll
                    for (int n = 0; n < 2; ++n) { const f32x4 a = acc[ai][bj][m][n] * rs; const int head = 2 * u.pn + bj, col = 32 * (wc & 1) + 16 * n + 4 * fq;
                        u32x2 w; w.x = cvt_pk_bf16_v(a[0], a[1]); w.y = cvt_pk_bf16_v(a[2], a[3]); bf16_t* dst = (wc < 2 ? KN : VM) + (size_t)row * 256 + 64 * head + col; *(u32x2*)dst = w; }
                asm volatile("" ::: "memory");
            }
    }
};
}

constexpr size_t MiB = 1u << 20;
constexpr size_t WS_CTL = 0, CTL_ZERO_BYTES = 1 * MiB;
constexpr size_t WS_SQ = 1 * MiB;
constexpr size_t WS_ROPE = 19 * MiB;
constexpr size_t WS_LF = 20 * MiB, WS_CL = 21 * MiB;
constexpr size_t WS_HGS = 22 * MiB;
constexpr size_t WS_W = 39 * MiB;
constexpr size_t WS_PB = 95 * MiB;
constexpr size_t WS_XB = 127 * MiB;
constexpr size_t WS_YS = 255 * MiB;
constexpr size_t WS_BIG = 383 * MiB, WS_END = 895 * MiB;
constexpr size_t BIG_MIX = 0, BIG_QM = 384 * MiB, BIG_KN = 432 * MiB, BIG_VM = 464 * MiB, BIG_KR = 496 * MiB;
constexpr size_t WO_FA1 = 0, WO_FA2 = WO_FA1 + (size_t)5632 * 1024, WO_FB1 = WO_FA2 + (size_t)1024 * 2816, WO_FB2 = WO_FB1 + (size_t)5632 * 1024, WO_MIX = WO_FB2 + (size_t)1024 * 2816,
    WO_GATE = WO_MIX + (size_t)3072 * 1024, WO_UQ = WO_GATE + (size_t)4096 * 1024, WO_UKV = WO_UQ + (size_t)512 * 256, WO_BR = WO_UKV + (size_t)512 * 256, WO_OUT = WO_BR + (size_t)4096 * 256,
    WO_PG = WO_OUT + (size_t)1024 * 1024, WO_PE = WO_PG + (size_t)1024 * 1024, WO_END = WO_PE + (size_t)1024 * 256;
static_assert(WO_END * 2 <= 56 * MiB, "weight copies fit");
constexpr int CW_BAR = 4096;

constexpr int RING_BYTES = 131072, LDSCTL_OFF = RING_BYTES, MISC_OFF = LDSCTL_OFF + 320, LDS_BYTES = 147456;
constexpr int NWAVES = 8;

#define RLX_AGENT __ATOMIC_RELAXED, __HIP_MEMORY_SCOPE_AGENT
#define LDS_WAIT() asm volatile("s_waitcnt lgkmcnt(0)" ::: "memory")
#define VM_WAIT() asm volatile("s_waitcnt vmcnt(0)" ::: "memory")

#define XB_TMO      128
#define XB_XCNT(j)  (256  + 64 * (j))
#define XB_XSUB(j)  (1280 + 64 * (j))
#define XB_XGEN(j)  (2304 + 64 * (j))
#define XB_TOP      3328
#define XB_TOPGEN   3392
#define XCD_BAR_WORDS 3456
#define XB_SPIN_CAP (1u << 20)
__device__ __forceinline__ unsigned xb_ld(unsigned* p)              { return __hip_atomic_load(p, __ATOMIC_RELAXED, __HIP_MEMORY_SCOPE_AGENT); }
__device__ __forceinline__ unsigned xb_add(unsigned* p, unsigned v) { return __hip_atomic_fetch_add(p, v, __ATOMIC_RELAXED, __HIP_MEMORY_SCOPE_AGENT); }
__device__ __forceinline__ unsigned xb_xcc_id() { return (unsigned)__builtin_amdgcn_s_getreg((3 << 11) | 20) & 0xFu; }
#define XB_SPIN(cond, bar) do { unsigned _sp = 0; while (cond) { __builtin_amdgcn_s_sleep(1); \
    if ((++_sp & 255u) == 0u) { if (xb_ld(&(bar)[XB_TMO])) break; if (_sp > XB_SPIN_CAP) { atomicAdd(&(bar)[XB_TMO], 1u); break; } } } } while (0)
struct XcdBarrier { unsigned* bar; unsigned x; volatile LAS unsigned* st; };
__device__ __forceinline__ XcdBarrier xcd_barrier_post(unsigned* bar, volatile LAS unsigned* st) {
    XcdBarrier b; b.bar = bar; b.x = xb_xcc_id(); b.st = st;
    if (threadIdx.x == 0) (void)xb_add(&bar[XB_XCNT(b.x)], 1u);
    return b;
}
__device__ __forceinline__ void xcd_barrier_complete(unsigned* bar, unsigned x, unsigned& nloc, unsigned& nx) {
    const unsigned G = gridDim.x * gridDim.y * gridDim.z;
    unsigned sum, cnt, mine, sp = 0u;
    for (;;) {
        sum = 0u; cnt = 0u; mine = 0u;
#pragma unroll
        for (unsigned j = 0; j < 16; ++j) { const unsigned c = xb_ld(&bar[XB_XCNT(j)]); sum += c; cnt += (c > 0u) ? 1u : 0u; mine = (j == x) ? c : mine; }
        if (sum == G) break;
        __builtin_amdgcn_s_sleep(1);
        if ((++sp & 255u) == 0u) { if (xb_ld(&bar[XB_TMO])) break; if (sp > XB_SPIN_CAP) { atomicAdd(&bar[XB_TMO], 1u); break; } }
    }
    nloc = mine > 0u ? mine : 1u; nx = cnt > 0u ? cnt : 1u;
}
__device__ __forceinline__ void xcd_barrier(const XcdBarrier& b) {
    asm volatile("s_waitcnt vmcnt(0)" ::: "memory");
    __syncthreads();
    if (threadIdx.x == 0) {
        unsigned* bar = b.bar;
        __builtin_amdgcn_s_waitcnt(0);
        unsigned nloc = b.st[0], nx = b.st[1];
        if (nloc == 0u) { xcd_barrier_complete(bar, b.x, nloc, nx); b.st[0] = nloc; b.st[1] = nx; }
        const unsigned old = xb_add(&bar[XB_XSUB(b.x)], 1u);
        const unsigned gen = old / nloc;
        if (old + 1u == (gen + 1u) * nloc) {
            __builtin_amdgcn_fence(__ATOMIC_RELEASE, "agent");
            asm volatile("s_waitcnt vmcnt(0)" ::: "memory");
            const unsigned og = xb_add(&bar[XB_TOP], 1u);
            const unsigned tg = og / nx;
            if (og + 1u == (tg + 1u) * nx) xb_add(&bar[XB_TOPGEN], 1u);
            else XB_SPIN(xb_ld(&bar[XB_TOPGEN]) == tg, bar);
            __builtin_amdgcn_fence(__ATOMIC_ACQUIRE, "agent");
            xb_add(&bar[XB_XGEN(b.x)], 1u);
            asm volatile("s_waitcnt vmcnt(0)" ::: "memory");
        } else {
            XB_SPIN(xb_ld(&bar[XB_XGEN(b.x)]) == gen, bar);
            __builtin_amdgcn_fence(__ATOMIC_ACQUIRE, "agent");
            asm volatile("s_waitcnt vmcnt(0)" ::: "memory");
        }
    }
    __syncthreads();
}

__device__ __forceinline__ float wave_sum(float v) {
#pragma unroll
    for (int o = 1; o < 64; o <<= 1) v += __shfl_xor(v, o);
    return v;
}
enum { MK_ID = 0, MK_FFN1 = 1, MK_MIX = 2, MK_GATE = 3, MK_UQ = 4 };
__device__ __forceinline__ int srcmap(int kind, int v, float& sc) {
    sc = 1.f;
    if (kind == MK_ID) return v;
    if (kind == MK_FFN1) { const int pn = v >> 8, r = v & 255; return r < 128 ? 128 * pn + r : FF + 128 * pn + (r - 128); }
    if (kind == MK_GATE) { const int pn = v >> 8, r = v & 255, bj = r >> 7, wc = (r >> 5) & 3, n = (r >> 4) & 1, jj = r & 15; return 2980 + 1024 * (2 * bj + n) + 64 * pn + 16 * wc + jj; }
    if (kind == MK_UQ) { sc = 0.10206207261596577f * LOG2E; if (v < 256) return 96 * (v >> 6) + (v & 63); if (v < 384) { const int w = v - 256; return 96 * (w >> 5) + 64 + (w & 31); } return -1; }
    const int t = v >> 8, r = v & 255;
    switch (t) {
        case 0: sc = 0.125f * LOG2E; return r;
        case 1: return 256 + r;
        case 2: return 512 + r;
        case 3: return 772 + r;
        case 4: if (r < 128) return 1028 + r; if (r < 160) return 1156 + (r - 128); if (r < 164) return 768 + (r - 160); return -1;
        case 5: sc = 0.125f * LOG2E; return 1188 + r;
        case 6: return 1444 + r;
        case 7: return 1700 + r;
        case 8: return 1956 + r;
        case 9: return 2212 + r;
        case 10: return 2468 + r;
        default: return 2724 + r;
    }
}
__device__ __forceinline__ void conv_item(const float* __restrict__ W, int ldw, int Ksrc, int K, const float* __restrict__ gain, bf16_t* WT, int kind, LAS float* scr, int it, int nblk, int lane) {
    const int kb = it / nblk, nb = it % nblk, k0 = 64 * kb, n0 = 32 * nb;
    float sc; const int c = srcmap(kind, n0 + (lane & 31), sc);
#pragma unroll 8
    for (int i = 0; i < 32; ++i) { const int kk = 2 * i + (lane >> 5), k = k0 + kk; float v = 0.f;
        if (c >= 0 && k < Ksrc) { v = W[(size_t)k * ldw + c] * sc; if (gain) v *= gain[k]; }
        scr[kk * 33 + (lane & 31)] = v; }
    LDS_WAIT(); asm volatile("" ::: "memory");
    const int ch = lane & 7;
#pragma unroll
    for (int j = 0; j < 4; ++j) { const int n = (lane >> 3) + 8 * j; const LAS float* s = scr + (8 * ch) * 33 + n;
        u32x4 o; o.x = cvt_pk_bf16(s[0 * 33], s[1 * 33]); o.y = cvt_pk_bf16(s[2 * 33], s[3 * 33]); o.z = cvt_pk_bf16(s[4 * 33], s[5 * 33]); o.w = cvt_pk_bf16(s[6 * 33], s[7 * 33]);
        *(u32x4*)(WT + (size_t)(n0 + n) * K + k0 + 8 * ch) = o; }
    LDS_WAIT(); asm volatile("" ::: "memory");
}
struct ConvCtx { LAS float* scr; int gw, NGW, lane, base; };
__device__ __forceinline__ void conv_mat(ConvCtx& C, const float* W, int ldw, int Ksrc, int K, int Nv, const float* gain, bf16_t* WT, int kind) {
    const int nblk = Nv / 32, n = (K / 64) * nblk;
    int it = C.gw - (C.base % C.NGW); if (it < 0) it += C.NGW;
    for (; it < n; it += C.NGW) conv_item(W, ldw, Ksrc, K, gain, WT, kind, C.scr, it, nblk, C.lane);
    C.base += n;
}

namespace att {
constexpr int KSLOT = 12288, VSLOT = 8192;
constexpr int LDS_K = 0, LDS_V = 2 * KSLOT, LDS_CLS = LDS_V + 2 * VSLOT, LDS_WS = LDS_CLS + 512, LDS_OST = LDS_WS + 8 * 256, LDS_FLAG = LDS_OST + 8 * 4096, LDS_BYTES = LDS_FLAG + 64;
static_assert(LDS_BYTES <= RING_BYTES, "attention scratch fits the ring region");
enum { FOX = 0, MLA = 1, SB = 2 };
struct Args { const bf16_t* Q; int ldq, hqs; const bf16_t* K; int ldk; const bf16_t* K2; const bf16_t* V; int ldv; const float* CL; bf16_t* O; };
__device__ __forceinline__ int crow(int r, int hi) { return (r & 3) + 8 * (r >> 2) + 4 * hi; }
__device__ __forceinline__ void glds16(const void* gsrc, unsigned lds_dst) { unsigned keep;
    asm volatile("s_mov_b32 %0, m0\n\ts_mov_b32 m0, %2\n\ts_nop 0\n\tglobal_load_lds_dwordx4 %1, off\n\ts_mov_b32 m0, %0" : "=&s"(keep) : "v"(gsrc), "s"(lds_dst) : "memory"); }
__device__ __forceinline__ void glds4(const void* gsrc, unsigned lds_dst) { unsigned keep;
    asm volatile("s_mov_b32 %0, m0\n\ts_mov_b32 m0, %2\n\ts_nop 0\n\tglobal_load_lds_dword %1, off\n\ts_mov_b32 m0, %0" : "=&s"(keep) : "v"(gsrc), "s"(lds_dst) : "memory"); }
#define ATT_MFMA(a, b, c) __builtin_amdgcn_mfma_f32_32x32x16_bf16(a, b, c, 0, 0, 0)
__device__ __forceinline__ void pv(f32x16* o, int vb, bf16x8 pa0, bf16x8 pa1, bf16x8 pa2, bf16x8 pa3) {
#pragma unroll
    for (int d0 = 0; d0 < 2; ++d0) { s16x4 lo[4], hi[4];
#pragma unroll
        for (int ks = 0; ks < 4; ++ks) {
            asm volatile("ds_read_b64_tr_b16 %0,%1 offset:%c2" : "=&v"(lo[ks]) : "v"(vb), "i"(d0 * 4096 + ks * 1024) : "memory");
            asm volatile("ds_read_b64_tr_b16 %0,%1 offset:%c2" : "=&v"(hi[ks]) : "v"(vb), "i"(d0 * 4096 + ks * 1024 + 512) : "memory"); }
        asm volatile("s_waitcnt lgkmcnt(0)" ::: "memory"); __builtin_amdgcn_sched_barrier(0);
#define ATT_PK(k) (bf16x8){lo[k][0], lo[k][1], lo[k][2], lo[k][3], hi[k][0], hi[k][1], hi[k][2], hi[k][3]}
        o[d0] = ATT_MFMA(pa0, ATT_PK(0), o[d0]); o[d0] = ATT_MFMA(pa1, ATT_PK(1), o[d0]); o[d0] = ATT_MFMA(pa2, ATT_PK(2), o[d0]); o[d0] = ATT_MFMA(pa3, ATT_PK(3), o[d0]);
#undef ATT_PK
    }
}
template <int MODE>
__device__ __forceinline__ void attn_unit(char* shm, int b, int h, int qb, const Args& A) {
    constexpr int NCH = (MODE == MLA) ? 12 : 8, NQ = NCH / 2;
    int tid_ = threadIdx.x; asm volatile("" : "+v"(tid_));
    const int tid = tid_, lane = tid & 63, r32 = lane & 31, hi = lane >> 5; const int wid = __builtin_amdgcn_readfirstlane(tid >> 6);
    const long rowbase = (long)b * SEQ; const int q0 = qb * 256;
    const unsigned lds0 = (unsigned)(uintptr_t)shm;
    float* wsf = (float*)(shm + LDS_WS) + wid * 64;
    const bf16_t* Qw = A.Q + (rowbase + q0 + wid * 32) * A.ldq + h * A.hqs;
    const bf16_t* Kh = A.K + rowbase * A.ldk + h * 64; const bf16_t* Vh = A.V + rowbase * A.ldv + h * 64;
    const bf16_t* ksrc = Kh + (long)lane * A.ldk + wid * 8;
    const bf16_t* ksrc2 = (MODE == MLA) ? A.K2 + (rowbase + lane) * 32 + (wid & 3) * 8 : nullptr;
    const bf16_t* vsrc = Vh + (long)(16 * (wid & 3) + (lane >> 2)) * A.ldv + (wid >> 2) * 32 + (lane & 3) * 8;
    const float* CLh = (MODE == FOX) ? A.CL + ((long)b * 4 + h) * SEQ : nullptr;
    const int NT = (q0 + 256) / 64;
#define ATT_DMA(t, s) do { const long kt_ = (long)(t) * 64; \
        glds16(ksrc + kt_ * A.ldk, (unsigned)__builtin_amdgcn_readfirstlane(lds0 + LDS_K + (s) * KSLOT + wid * 1024)); \
        glds16(vsrc + kt_ * A.ldv, (unsigned)__builtin_amdgcn_readfirstlane(lds0 + LDS_V + (s) * VSLOT + wid * 1024)); \
        if (MODE == MLA) { if (wid < 4) glds16(ksrc2 + kt_ * 32, (unsigned)__builtin_amdgcn_readfirstlane(lds0 + LDS_K + (s) * KSLOT + (8 + wid) * 1024)); } \
        if (MODE == FOX) { if (wid == 7) glds4(CLh + kt_ + lane, (unsigned)__builtin_amdgcn_readfirstlane(lds0 + LDS_CLS + (s) * 256)); } } while (0)
    const int t_first = (MODE == SB) ? NT - 1 : 0;
    ATT_DMA(t_first, 0);
    bf16x8 qr[NQ];
#pragma unroll
    for (int d0 = 0; d0 < NQ; ++d0) qr[d0] = *reinterpret_cast<const bf16x8*>(&Qw[(long)r32 * A.ldq + d0 * 16 + hi * 8]);
    const int qg = q0 + wid * 32 + r32;
    float clq = 0.f; if (MODE == FOX) clq = CLh[qg];
    f32x16 o[2]; o[0] = f32x16{}; o[1] = f32x16{};
    float mrun = -INFINITY, lrun = 0.f, Rrun = 0.f;
    const int vb0 = (int)(lds0 + LDS_V) + ((lane >> 4) & 1) * 32 + (lane & 3) * 8 + (4 * hi + ((lane & 15) >> 2)) * 64;
    volatile int* flags = (volatile int*)(shm + LDS_FLAG);
    if (MODE == SB) { if (tid < 16) flags[tid] = 0; }
    for (int it = 0; it < NT; ++it) {
        const int t = (MODE == SB) ? NT - 1 - it : it, s = it & 1;
        asm volatile("s_waitcnt vmcnt(0) lgkmcnt(0)\n\ts_barrier" ::: "memory");
        if (MODE == SB) { if (it > 0) { int alld = 1;
#pragma unroll
                for (int w = 0; w < 8; ++w) alld &= flags[((it - 1) & 1) * 8 + w];
                if (alld) break; } }
        if (it + 1 < NT) ATT_DMA((MODE == SB) ? t - 1 : t + 1, s ^ 1);
        const char* Ks = shm + LDS_K + s * KSLOT + hi * 1024 + r32 * 16;
        f32x16 p0 = f32x16{}, p1 = f32x16{};
#pragma unroll
        for (int d0 = 0; d0 < NQ; ++d0) { const bf16x8 b0 = *reinterpret_cast<const bf16x8*>(Ks + d0 * 2048), b1 = *reinterpret_cast<const bf16x8*>(Ks + d0 * 2048 + 512);
            p0 = ATT_MFMA(b0, qr[d0], p0); p1 = ATT_MFMA(b1, qr[d0], p1); }
        const int kbase = 64 * t + 4 * hi;
        bf16x8 pa0, pa1, pa2, pa3;
        if (MODE != SB) {
            if (MODE == FOX) { const float* cls = (const float*)(shm + LDS_CLS + s * 256);
#pragma unroll
                for (int g = 0; g < 4; ++g) { const f32x4 c0 = *(const f32x4*)(cls + 8 * g + 4 * hi), c1 = *(const f32x4*)(cls + 32 + 8 * g + 4 * hi);
#pragma unroll
                    for (int i = 0; i < 4; ++i) { p0[4 * g + i] += clq - c0[i]; p1[4 * g + i] += clq - c1[i]; } } }
            if (t >= NT - 4) {
#pragma unroll
                for (int r = 0; r < 16; ++r) { const int kv = kbase + (r & 3) + 8 * (r >> 2); if (kv > qg) p0[r] = -INFINITY; if (kv + 32 > qg) p1[r] = -INFINITY; } }
            float rm = fmaxf(p0[0], p1[0]);
#pragma unroll
            for (int r = 1; r < 16; ++r) rm = fmaxf(rm, fmaxf(p0[r], p1[r]));
            rm = fmaxf(rm, __shfl_xor(rm, 32));
            const bool grow = rm > mrun;
            if (__any(grow)) {
                const float mnew = fmaxf(mrun, rm), alpha = fast_exp2(mrun - mnew); mrun = mnew; lrun *= alpha;
                if (hi == 0) wsf[r32] = alpha;
                LDS_WAIT();
#pragma unroll
                for (int g = 0; g < 4; ++g) { const f32x4 a4 = *(const f32x4*)(wsf + 8 * g + 4 * hi);
#pragma unroll
                    for (int i = 0; i < 4; ++i) { o[0][4 * g + i] *= a4[i]; o[1][4 * g + i] *= a4[i]; } }
            }
            float sacc = 0.f;
#pragma unroll
            for (int r = 0; r < 16; ++r) { p0[r] = fast_exp2(p0[r] - mrun); p1[r] = fast_exp2(p1[r] - mrun); sacc += p0[r] + p1[r]; }
            lrun += sacc;
        } else {
            f32x16 l0, l1;
#pragma unroll
            for (int r = 0; r < 16; ++r) { const int kv = kbase + (r & 3) + 8 * (r >> 2);
                { const float z = p0[r], sp = fmaxf(z, 0.f) + fast_log2(1.f + fast_exp2(-fabsf(z))); const bool ok = kv < qg; l0[r] = ok ? -sp : 0.f; p0[r] = ok ? z - sp : -INFINITY; }
                { const float z = p1[r], sp = fmaxf(z, 0.f) + fast_log2(1.f + fast_exp2(-fabsf(z))); const bool ok = kv + 32 < qg; l1[r] = ok ? -sp : 0.f; p1[r] = ok ? z - sp : -INFINITY; } }
            float gs[8], og[8];
#pragma unroll
            for (int g = 0; g < 4; ++g) { gs[g] = (l0[4 * g] + l0[4 * g + 1]) + (l0[4 * g + 2] + l0[4 * g + 3]); gs[4 + g] = (l1[4 * g] + l1[4 * g + 1]) + (l1[4 * g + 2] + l1[4 * g + 3]); }
#pragma unroll
            for (int g = 0; g < 8; ++g) og[g] = __shfl_xor(gs[g], 32);
            float run = Rrun;
#pragma unroll
            for (int g = 7; g >= 0; --g) {
                const float aft = run + (hi == 0 ? og[g] : 0.f);
                if (g >= 4) { const int r = 4 * (g - 4); float c = aft; p1[r + 3] = fast_exp2(p1[r + 3] + c); c += l1[r + 3]; p1[r + 2] = fast_exp2(p1[r + 2] + c); c += l1[r + 2]; p1[r + 1] = fast_exp2(p1[r + 1] + c); c += l1[r + 1]; p1[r] = fast_exp2(p1[r] + c); }
                else        { const int r = 4 * g;       float c = aft; p0[r + 3] = fast_exp2(p0[r + 3] + c); c += l0[r + 3]; p0[r + 2] = fast_exp2(p0[r + 2] + c); c += l0[r + 2]; p0[r + 1] = fast_exp2(p0[r + 1] + c); c += l0[r + 1]; p0[r] = fast_exp2(p0[r] + c); }
                run += gs[g] + og[g];
            }
            Rrun = run;
            const int done = __all(Rrun < -160.f) ? 1 : 0;
            if (lane == 0) flags[(it & 1) * 8 + wid] = done;
        }
        pa0 = __builtin_bit_cast(bf16x8, (u32x4){cvt_pk_bf16(p0[0], p0[1]), cvt_pk_bf16(p0[2], p0[3]), cvt_pk_bf16(p0[4], p0[5]), cvt_pk_bf16(p0[6], p0[7])});
        pa1 = __builtin_bit_cast(bf16x8, (u32x4){cvt_pk_bf16(p0[8], p0[9]), cvt_pk_bf16(p0[10], p0[11]), cvt_pk_bf16(p0[12], p0[13]), cvt_pk_bf16(p0[14], p0[15])});
        pa2 = __builtin_bit_cast(bf16x8, (u32x4){cvt_pk_bf16(p1[0], p1[1]), cvt_pk_bf16(p1[2], p1[3]), cvt_pk_bf16(p1[4], p1[5]), cvt_pk_bf16(p1[6], p1[7])});
        pa3 = __builtin_bit_cast(bf16x8, (u32x4){cvt_pk_bf16(p1[8], p1[9]), cvt_pk_bf16(p1[10], p1[11]), cvt_pk_bf16(p1[12], p1[13]), cvt_pk_bf16(p1[14], p1[15])});
        pv(o, vb0 + s * VSLOT, pa0, pa1, pa2, pa3);
    }
    float rli[16];
    if (MODE != SB) {
        lrun += __shfl_xor(lrun, 32);
        if (hi == 0) wsf[32 + r32] = lrun;
        LDS_WAIT();
#pragma unroll
        for (int r = 0; r < 16; ++r) rli[r] = fast_rcp(wsf[32 + crow(r, hi)]);
    } else {
#pragma unroll
        for (int r = 0; r < 16; ++r) rli[r] = 1.f;
    }
    bf16_t* Ow = A.O + (rowbase + q0 + wid * 32) * DM + h * 64;
    { __hip_bfloat16* stg = (__hip_bfloat16*)(shm + LDS_OST) + wid * 2048;
#pragma unroll
        for (int r = 0; r < 16; ++r) { const int orow = crow(r, hi);
#pragma unroll
            for (int d0 = 0; d0 < 2; ++d0) stg[orow * 64 + d0 * 32 + r32] = __float2bfloat16(o[d0][r] * rli[r]); }
        LDS_WAIT();
#pragma unroll
        for (int i = 0; i < 4; ++i) { const int row = i * 8 + (lane >> 3), ch = lane & 7; const u32x4 v = *(const u32x4*)(stg + row * 64 + ch * 8); *(u32x4*)(Ow + (long)row * DM + ch * 8) = v; } }
    asm volatile("s_waitcnt vmcnt(0) lgkmcnt(0)\n\ts_barrier" ::: "memory");
#undef ATT_DMA
}
#undef ATT_MFMA
}

namespace hg {
constexpr int PT = 68;
constexpr int L_S = 0, L_QX = L_S + 64 * PT, L_QR = L_QX + 32 * PT, L_KR = L_QR + 32 * PT, L_KD = L_KR + 32 * PT, L_V = L_KD + 32 * PT, L_BC = L_V + 32 * PT, L_SC = L_BC + 32 * PT, L_BL = L_SC + 32 * 36, L_END = L_BL + 64;
static_assert(L_END * 4 <= RING_BYTES, "HGRN scratch fits the ring region");
struct Args { const bf16_t* MIX; const float* lb_logits; const float* out_norm; float* SLOC; float* LSEG; bf16_t* YS; int layer; };
template <bool STAGE2>
__device__ __forceinline__ void load_chunk(LAS float* L, const Args& A, long row0, int h, const float (&lbv)[4], float (&seglog)[4], int wid, int lane) {
    const int t = lane & 31, d0 = 8 * wid + 4 * (lane >> 5);
    const bf16_t* src = A.MIX + (row0 + t) * NMIX + 64 * h + d0;
    const u32x2 wq = *(const u32x2*)(src + MX_HQ), wf = *(const u32x2*)(src + MX_HF), wi = *(const u32x2*)(src + MX_HI);
    const float q[4] = {bf_lo(wq.x), bf_hi(wq.x), bf_lo(wq.y), bf_hi(wq.y)}, hf[4] = {bf_lo(wf.x), bf_hi(wf.x), bf_lo(wf.y), bf_hi(wf.y)}, v[4] = {bf_lo(wi.x), bf_hi(wi.x), bf_lo(wi.y), bf_hi(wi.y)};
    float k[4], bc[4];
#pragma unroll
    for (int i = 0; i < 4; ++i) { const float f = lbv[i] + (1.f - lbv[i]) * sigmoidf_(hf[i]); k[i] = 1.f - f; bc[i] = LN2 * fast_log2(f); }
#pragma unroll
    for (int off = 1; off < 32; off <<= 1) {
#pragma unroll
        for (int i = 0; i < 4; ++i) { const float y = __shfl_up(bc[i], off, 32); if (t >= off) bc[i] += y; } }
    float bl[4];
#pragma unroll
    for (int i = 0; i < 4; ++i) bl[i] = __shfl(bc[i], 31, 32);
#pragma unroll
    for (int i = 0; i < 4; ++i) { const int o = t * PT + d0 + i;
        if (STAGE2) { L[L_QR + o] = q[i]; L[L_QX + o] = q[i] * fast_exp2(bc[i] * LOG2E); L[L_KR + o] = k[i]; L[L_BC + o] = bc[i]; }
        L[L_KD + o] = k[i] * fast_exp2((bl[i] - bc[i]) * LOG2E); L[L_V + o] = v[i];
        if (t == 31) { L[L_BL + d0 + i] = fast_exp2(bl[i] * LOG2E); seglog[i] += bl[i]; } }
}
__device__ __forceinline__ void state_update(LAS float* L, int tid) {
    const int d = tid >> 3, v8 = 8 * (tid & 7);
    f32x4 s0 = *(LAS f32x4*)(L + L_S + d * PT + v8), s1 = *(LAS f32x4*)(L + L_S + d * PT + v8 + 4); const float e = L[L_BL + d];
    s0 *= e; s1 *= e;
#pragma unroll 8
    for (int s = 0; s < 32; ++s) { const float kd = L[L_KD + s * PT + d]; const f32x4 a = *(LAS f32x4*)(L + L_V + s * PT + v8), b = *(LAS f32x4*)(L + L_V + s * PT + v8 + 4); s0 += kd * a; s1 += kd * b; }
    *(LAS f32x4*)(L + L_S + d * PT + v8) = s0; *(LAS f32x4*)(L + L_S + d * PT + v8 + 4) = s1;
}
__device__ __forceinline__ void lower_bounds(const Args& A, int h, int d0, float (&lbv)[4]) {
#pragma unroll
    for (int i = 0; i < 4; ++i) { const int c = 64 * h + d0 + i; float lg[4], mx = -INFINITY;
#pragma unroll
        for (int l = 0; l < 4; ++l) { lg[l] = A.lb_logits[l * 256 + c]; mx = fmaxf(mx, lg[l]); }
        float den = 0.f, num = 0.f;
#pragma unroll
        for (int l = 0; l < 4; ++l) { const float e = __expf(lg[l] - mx); den += e; if (l >= 1 && l <= A.layer) num += e; }
        lbv[i] = num / den; }
}
__device__ __forceinline__ void stage1_unit(LAS float* L, const Args& A, int bh, int seg) {
    int tid_ = threadIdx.x; asm volatile("" : "+v"(tid_));
    const int tid = tid_, lane = tid & 63, wid = __builtin_amdgcn_readfirstlane(tid >> 6);
    const int h = bh & 3; const long row0 = (long)(bh >> 2) * SEQ + seg * 256; const int d0 = 8 * wid + 4 * (lane >> 5);
    float lbv[4]; lower_bounds(A, h, d0, lbv);
    float seglog[4] = {0.f, 0.f, 0.f, 0.f};
    for (int i = tid; i < 64 * PT; i += 512) L[L_S + i] = 0.f;
    for (int c = 0; c < 8; ++c) {
        load_chunk<false>(L, A, row0 + 32 * c, h, lbv, seglog, wid, lane);
        __syncthreads();
        state_update(L, tid);
        __syncthreads();
    }
    const int u = bh * 32 + seg; const int d = tid >> 3, v8 = 8 * (tid & 7);
    *(f32x4*)(A.SLOC + ((size_t)u * 64 + d) * 64 + v8) = *(LAS f32x4*)(L + L_S + d * PT + v8); *(f32x4*)(A.SLOC + ((size_t)u * 64 + d) * 64 + v8 + 4) = *(LAS f32x4*)(L + L_S + d * PT + v8 + 4);
    if ((lane & 31) == 31) { *(f32x4*)(A.LSEG + (size_t)u * 64 + d0) = (f32x4){seglog[0], seglog[1], seglog[2], seglog[3]}; }
    __syncthreads();
}
__device__ __forceinline__ void stage2_unit(LAS float* L, const Args& A, int bh, int seg) {
    int tid_ = threadIdx.x; asm volatile("" : "+v"(tid_));
    const int tid = tid_, lane = tid & 63, wid = __builtin_amdgcn_readfirstlane(tid >> 6);
    const int h = bh & 3; const long row0 = (long)(bh >> 2) * SEQ + seg * 256; const int d0 = 8 * wid + 4 * (lane >> 5);
    float lbv[4]; lower_bounds(A, h, d0, lbv);
    float seglog[4] = {0.f, 0.f, 0.f, 0.f};
    {
        const int d = tid >> 3, v8 = 8 * (tid & 7); f32x4 s0 = {0.f, 0.f, 0.f, 0.f}, s1 = {0.f, 0.f, 0.f, 0.f};
        for (int j = 0; j < seg; ++j) { const int u = bh * 32 + j; const float e = __expf(A.LSEG[(size_t)u * 64 + d]);
            const f32x4 a = *(const f32x4*)(A.SLOC + ((size_t)u * 64 + d) * 64 + v8), b = *(const f32x4*)(A.SLOC + ((size_t)u * 64 + d) * 64 + v8 + 4); s0 = s0 * e + a; s1 = s1 * e + b; }
        *(LAS f32x4*)(L + L_S + d * PT + v8) = s0; *(LAS f32x4*)(L + L_S + d * PT + v8 + 4) = s1; }
    for (int c = 0; c < 8; ++c) {
        const long crow0 = row0 + 32 * c;
        load_chunk<true>(L, A, crow0, h, lbv, seglog, wid, lane);
        __syncthreads();
        {
            const int t = tid >> 4, s0i = 2 * (tid & 15); float a0 = 0.f, a1 = 0.f;
            if (s0i <= t) {
#pragma unroll 4
                for (int d4 = 0; d4 < 16; ++d4) { const f32x4 q4 = *(LAS f32x4*)(L + L_QR + t * PT + 4 * d4), bt = *(LAS f32x4*)(L + L_BC + t * PT + 4 * d4);
                    const f32x4 k0 = *(LAS f32x4*)(L + L_KR + s0i * PT + 4 * d4), b0 = *(LAS f32x4*)(L + L_BC + s0i * PT + 4 * d4);
                    const f32x4 k1 = *(LAS f32x4*)(L + L_KR + (s0i + 1) * PT + 4 * d4), b1 = *(LAS f32x4*)(L + L_BC + (s0i + 1) * PT + 4 * d4);
#pragma unroll
                    for (int i = 0; i < 4; ++i) { a0 += q4[i] * k0[i] * fast_exp2((bt[i] - b0[i]) * LOG2E); a1 += q4[i] * k1[i] * fast_exp2(fminf(bt[i] - b1[i], 0.f) * LOG2E); } }
                if (s0i + 1 > t) a1 = 0.f;
            }
            L[L_SC + t * 36 + s0i] = a0; L[L_SC + t * 36 + s0i + 1] = a1; }
        __syncthreads();
        {
            const int t = tid >> 4, v4 = 4 * (tid & 15); f32x4 o = {0.f, 0.f, 0.f, 0.f};
            for (int s = 0; s <= t; ++s) { const float sc = L[L_SC + t * 36 + s]; o += sc * *(LAS f32x4*)(L + L_V + s * PT + v4); }
#pragma unroll 8
            for (int d = 0; d < 64; ++d) { const float qx = L[L_QX + t * PT + d]; o += qx * *(LAS f32x4*)(L + L_S + d * PT + v4); }
            float ss = (o[0] * o[0] + o[1] * o[1]) + (o[2] * o[2] + o[3] * o[3]);
            ss += __shfl_xor(ss, 1); ss += __shfl_xor(ss, 2); ss += __shfl_xor(ss, 4); ss += __shfl_xor(ss, 8);
            const float rs = __builtin_amdgcn_rsqf(ss * (1.f / 64.f) + EPS);
            const f32x4 gn = *(const f32x4*)(A.out_norm + 64 * h + v4);
            const u32x2 wg = *(const u32x2*)(A.MIX + (crow0 + t) * NMIX + MX_HG + 64 * h + v4);
            const float g[4] = {bf_lo(wg.x), bf_hi(wg.x), bf_lo(wg.y), bf_hi(wg.y)}; float y[4];
#pragma unroll
            for (int i = 0; i < 4; ++i) y[i] = o[i] * rs * gn[i] * (g[i] * sigmoidf_(g[i]));
            u32x2 w; w.x = cvt_pk_bf16(y[0], y[1]); w.y = cvt_pk_bf16(y[2], y[3]);
            *(u32x2*)(A.YS + (crow0 + t) * DM + 768 + 64 * h + v4) = w; }
        __syncthreads();
        state_update(L, tid);
        __syncthreads();
    }
}
}

constexpr int N_PHASES = 50;
#ifndef MK_PER_PHASE
#define MK_PER_PHASE 1
#endif
struct KArgs { const float* in[20]; float* out; unsigned char* ws; int ph_lo, ph_hi, li, pad; };

__global__ void __launch_bounds__(NWAVES * 64, 2) fwd(KArgs a) {
    extern __shared__ __attribute__((aligned(16))) unsigned char lds[];
    LAS unsigned char* L = (LAS unsigned char*)lds;
    volatile LAS unsigned* MISC = (volatile LAS unsigned*)(L + MISC_OFF);
    unsigned char* ws = a.ws;
    for (int u = threadIdx.x; u < (LDS_BYTES - LDSCTL_OFF) / 4; u += NWAVES * 64) ((LAS unsigned*)(L + LDSCTL_OFF))[u] = 0u;
    __syncthreads();
    XcdBarrier bar = xcd_barrier_post((unsigned*)(ws + WS_CTL) + CW_BAR + a.li * XCD_BAR_WORDS, MISC + 8);
    const int lo = a.ph_lo, hi = a.ph_hi;
#ifndef EN_MASK
#define EN_MASK 0xFFFFFFFFu
#endif
#define EN(b) ((EN_MASK >> (b)) & 1u)
#define IN(k) (lo <= (k) && (k) < hi)
#define SEAM(k) do { if (IN(k) && IN((k) + 1)) xcd_barrier(bar); } while (0)
#define DEFPTRS const __attribute__((address_space(4))) KArgs* ka = (const __attribute__((address_space(4))) KArgs*)__builtin_amdgcn_kernarg_segment_ptr(); asm volatile("" : "+s"(ka)); unsigned char* wsl = ka->ws; int tid = threadIdx.x; asm volatile("" : "+v"(tid)); const int lane = tid & 63, wave = __builtin_amdgcn_readfirstlane(tid >> 6); int bxl = blockIdx.x; asm volatile("" : "+s"(bxl)); const int G = gridDim.x; const int vcu = (G % 8 == 0) ? (bxl % 8) * (G / 8) + bxl / 8 : bxl; const int gw = vcu * NWAVES + wave, NGW = G * NWAVES; (void)lane; (void)gw; (void)NGW; float* SQ = (float*)(wsl + WS_SQ); float* ROPEC = (float*)(wsl + WS_ROPE); float* ROPES = ROPEC + SEQ * 16; float* LF = (float*)(wsl + WS_LF); float* CL = (float*)(wsl + WS_CL); float* SLOC = (float*)(wsl + WS_HGS); float* LSEG = SLOC + (size_t)1024 * 4096; bf16_t* W = (bf16_t*)(wsl + WS_W); bf16_t* PB = (bf16_t*)(wsl + WS_PB); bf16_t* XB = (bf16_t*)(wsl + WS_XB); bf16_t* XBA = (bf16_t*)(wsl + WS_BIG + BIG_QM); bf16_t* YS = (bf16_t*)(wsl + WS_YS); bf16_t* MIX = (bf16_t*)(wsl + WS_BIG + BIG_MIX); bf16_t* QM = (bf16_t*)(wsl + WS_BIG + BIG_QM); bf16_t* KN = (bf16_t*)(wsl + WS_BIG + BIG_KN); bf16_t* VM = (bf16_t*)(wsl + WS_BIG + BIG_VM); bf16_t* KR = (bf16_t*)(wsl + WS_BIG + BIG_KR); bf16_t* PBUF = (bf16_t*)(wsl + WS_BIG); bf16_t* HB = (bf16_t*)(wsl + WS_BIG); float* X = ka->out;

    if (EN(0) && IN(0)) { DEFPTRS;
        for (int idx = gw * 64 + lane; idx < SEQ * 16; idx += NGW * 64) {
            const int pos = idx >> 4, i = idx & 15;
            const double inv = exp2(-(double)i * (13.287712379549449 / 16.0));
            const double ang = (double)pos * inv;
            const double kq = rint(ang * 0.6366197723675814); const double y = fma(-kq, 1.5707963267948966, ang) - kq * 6.123233995736766e-17; const double y2 = y * y;
            const double sy = y * (1.0 + y2 * (-1.0 / 6 + y2 * (1.0 / 120 + y2 * (-1.0 / 5040 + y2 * (1.0 / 362880 + y2 * (-1.0 / 39916800 + y2 * (1.0 / 6227020800.0)))))));
            const double cy = 1.0 + y2 * (-0.5 + y2 * (1.0 / 24 + y2 * (-1.0 / 720 + y2 * (1.0 / 40320 + y2 * (-1.0 / 3628800 + y2 * (1.0 / 479001600.0))))));
            const int qd = ((int)((long long)kq & 3));
            const double sn = (qd == 0) ? sy : (qd == 1) ? cy : (qd == 2) ? -sy : -cy, cs = (qd == 0) ? cy : (qd == 1) ? -sy : (qd == 2) ? -cy : sy;
            ROPEC[idx] = (float)cs; ROPES[idx] = (float)sn;
        }
        const float* xin = ka->in[0];
        for (int row = gw; row < NTOK; row += NGW) {
            const f32x4* xr = (const f32x4*)(xin + (size_t)row * DM) + lane; unsigned long long* o8 = (unsigned long long*)(XBA + (size_t)row * DM) + lane; float s = 0.f;
#pragma unroll
            for (int j = 0; j < 4; ++j) { const f32x4 v = xr[64 * j]; s += (v[0] * v[0] + v[1] * v[1]) + (v[2] * v[2] + v[3] * v[3]);
                o8[64 * j] = (unsigned long long)cvt_pk_bf16(v[0], v[1]) | ((unsigned long long)cvt_pk_bf16(v[2], v[3]) << 32); }
            s = wave_sum(s); if (lane < 16) SQ[(size_t)row * 16 + lane] = (lane == 0) ? s : 0.f;
        }
    }
    SEAM(0);

    for (int layer = 0; layer < DEPTH; ++layer) {
        const int pb = 1 + 12 * layer;
#define LAYERPTRS const float* norms = ka->in[18] + (size_t)layer * 4 * DM; float* sq0 = SQ; float* sq1 = SQ + (size_t)1 * NTOK * 16; float* sq2 = SQ + (size_t)2 * NTOK * 16; float* sq3 = SQ + (size_t)3 * NTOK * 16; float* sq4 = SQ; float* sqq = SQ + (size_t)4 * NTOK * 16; float* sqkv = sqq + (size_t)NTOK * 4; (void)sq0; (void)sq1; (void)sq2; (void)sq3; (void)sq4; (void)sqq; (void)sqkv; (void)norms;

        if (EN(1) && IN(pb + 0)) { DEFPTRS; LAYERPTRS;
            ConvCtx C; C.scr = (LAS float*)(L + wave * 16384); C.gw = gw; C.NGW = NGW; C.lane = lane; C.base = 0;
            conv_mat(C, ka->in[12] + (size_t)layer * DM * 2 * FF, 2 * FF, DM, DM, 2 * FF, norms + 0 * DM, W + WO_FA1, MK_FFN1);
            conv_mat(C, ka->in[13] + (size_t)layer * FF * DM, DM, FF, FF, DM, nullptr, W + WO_FA2, MK_ID);
            conv_mat(C, ka->in[14] + (size_t)layer * DM * 2 * FF, 2 * FF, DM, DM, 2 * FF, norms + 2 * DM, W + WO_FB1, MK_FFN1);
            conv_mat(C, ka->in[15] + (size_t)layer * FF * DM, DM, FF, FF, DM, nullptr, W + WO_FB2, MK_ID);
            conv_mat(C, ka->in[2] + (size_t)layer * DM * INCOLS, INCOLS, DM, DM, NMIX, norms + 1 * DM, W + WO_MIX, MK_MIX);
            conv_mat(C, ka->in[2] + (size_t)layer * DM * INCOLS, INCOLS, DM, DM, NGATE, norms + 1 * DM, W + WO_GATE, MK_GATE);
            conv_mat(C, ka->in[5] + (size_t)layer * 256 * 384, 384, 256, 256, 512, ka->in[4] + layer * 256, W + WO_UQ, MK_UQ);
            conv_mat(C, ka->in[7] + (size_t)layer * 128 * 512, 512, 128, 256, 512, ka->in[6] + layer * 128, W + WO_UKV, MK_ID);
            for (int nb = 0; nb < 4; ++nb) conv_mat(C, ka->in[10] + ((size_t)layer * 4 + nb) * 256 * DM, DM, 256, 256, DM, nullptr, W + WO_BR + (size_t)nb * DM * 256, MK_ID);
            conv_mat(C, ka->in[11] + (size_t)layer * DM * DM, DM, DM, DM, DM, nullptr, W + WO_OUT, MK_ID);
            conv_mat(C, ka->in[17] + (size_t)layer * DM * DM, DM, DM, DM, DM, norms + 3 * DM, W + WO_PG, MK_ID);
            conv_mat(C, ka->in[16] + (size_t)layer * PLE * DM, DM, PLE, PLE, DM, nullptr, W + WO_PE, MK_ID);
            const f32x4* ps = (const f32x4*)(ka->in[1] + (size_t)layer * NTOK * PLE); u32x2* pd = (u32x2*)PB;
            for (int i = gw * 64 + lane; i < NTOK * PLE / 4; i += NGW * 64) { const f32x4 v = ps[i]; u32x2 w; w.x = cvt_pk_bf16(v[0], v[1]); w.y = cvt_pk_bf16(v[2], v[3]); pd[i] = w; }
            LDS_WAIT(); __syncthreads();
        }
        SEAM(pb + 0);

        if (EN(2) && IN(pb + 1)) { DEFPTRS; LAYERPTRS;
            pg8::Gemm g{XBA, W + WO_FA1, NTOK, 2 * FF, DM, DM, DM, 0, 0}; pg8::StaticOrder S; S.init(NTOK, 2 * FF, G, bxl);
            pg8::EpiSwiglu E{HB, sq0}; pg8::gemm_phase(L, g, S, E);
        }
        SEAM(pb + 1);
        if (EN(3) && IN(pb + 2)) { DEFPTRS; LAYERPTRS;
            pg8::Gemm g{HB, W + WO_FA2, NTOK, DM, FF, FF, FF, 0, 0}; pg8::StaticOrder S; S.init(NTOK, DM, G, bxl);
            pg8::EpiResid E{layer == 0 ? ka->in[0] : (const float*)X, X, XB, sq1, 0.5f}; pg8::gemm_phase(L, g, S, E);
        }
        SEAM(pb + 2);
        if (EN(4) && IN(pb + 3)) { DEFPTRS; LAYERPTRS;
            pg8::Gemm g{XB, W + WO_MIX, NTOK, NMIX, DM, DM, DM, 0, 0}; pg8::StaticOrder S; S.init(NTOK, NMIX, G, bxl);
            pg8::EpiMix E{MIX, sq1, sqq, sqkv, KR, LF, ROPEC, ROPES, ka->in[3] + layer * 4}; pg8::gemm_phase(L, g, S, E);
        }
        SEAM(pb + 3);
        if (EN(5) && IN(pb + 4)) { DEFPTRS; LAYERPTRS;
            if (EN(16) && wave == 0 && vcu < 32) {
                const int b = vcu >> 2, h = vcu & 3; float carry = 0.f;
                for (int c = 0; c < SEQ / 64; ++c) { float v = LF[((size_t)b * SEQ + 64 * c + lane) * 4 + h];
#pragma unroll
                    for (int off = 1; off < 64; off <<= 1) { const float y = __shfl_up(v, off); if (lane >= off) v += y; }
                    v += carry; CL[(size_t)vcu * SEQ + 64 * c + lane] = v * LOG2E; carry = __shfl(v, 63); }
            }
            if (EN(17)) { pg8::Gemm g{MIX + MX_MCQ, W + WO_UQ, NTOK, 512, 256, NMIX, 256, 0, 0}; pg8::StaticOrder S; S.init(NTOK, 512, G, bxl);
              pg8::EpiQup E{QM, sqq, ROPEC, ROPES}; pg8::gemm_phase(L, g, S, E); }
            if (EN(18)) { pg8::Gemm g{MIX + MX_T4, W + WO_UKV, NTOK, 512, 256, NMIX, 256, 0, 0}; pg8::StaticOrder S; S.init(NTOK, 512, G, bxl);
              pg8::EpiKVup E{KN, VM, sqkv}; pg8::gemm_phase(L, g, S, E); }
            if (EN(19)) { hg::Args HA{MIX, ka->in[8], ka->in[9] + layer * 256, SLOC, LSEG, YS, layer};
              for (int u = vcu; u < 1024; u += G) hg::stage1_unit((LAS float*)L, HA, u >> 5, u & 31); }
        }
        SEAM(pb + 4);
        if (EN(6) && IN(pb + 5)) { DEFPTRS; LAYERPTRS;
#define UNIT_OF(idx, bh, qb) const int quarter_ = (idx) >> 8, rem_ = (idx) & 255, s_ = rem_ & 7; const int bh = rem_ >> 3, qb = quarter_ == 0 ? s_ : quarter_ == 1 ? 15 - s_ : quarter_ == 2 ? 16 + s_ : 31 - s_;
            { const att::Args A{MIX + MX_FQ, NMIX, 64, MIX + MX_FK, NMIX, nullptr, MIX + MX_FV, NMIX, CL, YS + 0};
              for (int idx = vcu; idx < 1024; idx += G) { UNIT_OF(idx, bh, qb); att::attn_unit<att::FOX>((char*)lds, bh >> 2, bh & 3, qb, A); } }
            { const att::Args A{QM, 384, 96, KN, 256, KR, VM, 256, nullptr, YS + 256};
              for (int idx = vcu; idx < 1024; idx += G) { UNIT_OF(idx, bh, qb); att::attn_unit<att::MLA>((char*)lds, bh >> 2, bh & 3, qb, A); } }
            { const att::Args A{MIX + MX_SQ, NMIX, 64, MIX + MX_SK, NMIX, nullptr, MIX + MX_SV, NMIX, nullptr, YS + 512};
              for (int idx = vcu; idx < 1024; idx += G) { UNIT_OF(idx, bh, qb); att::attn_unit<att::SB>((char*)lds, bh >> 2, bh & 3, qb, A); } }
            { hg::Args HA{MIX, ka->in[8], ka->in[9] + layer * 256, SLOC, LSEG, YS, layer};
              for (int u = vcu; u < 1024; u += G) hg::stage2_unit((LAS float*)L, HA, u >> 5, u & 31); }
#undef UNIT_OF
        }
        SEAM(pb + 5);
        if (EN(7) && IN(pb + 6)) { DEFPTRS; LAYERPTRS;
            pg8::Gemm g{YS, W + WO_BR, NTOK, NGATE, 256, DM, 256, 2, 256}; pg8::StaticOrder S; S.init(NTOK, NGATE, G, bxl);
            pg8::EpiBf16<NGATE> E{PBUF}; pg8::gemm_phase(L, g, S, E);
        }
        SEAM(pb + 6);
        if (EN(8) && IN(pb + 7)) { DEFPTRS; LAYERPTRS;
            pg8::Gemm g{XB, W + WO_GATE, NTOK, NGATE, DM, DM, DM, 0, 0}; pg8::StaticOrder S; S.init(NTOK, NGATE, G, bxl);
            pg8::EpiGate E{YS, PBUF, sq1}; pg8::gemm_phase(L, g, S, E);
        }
        SEAM(pb + 7);
        if (EN(9) && IN(pb + 8)) { DEFPTRS; LAYERPTRS;
            pg8::Gemm g{YS, W + WO_OUT, NTOK, DM, DM, DM, DM, 0, 0}; pg8::StaticOrder S; S.init(NTOK, DM, G, bxl);
            pg8::EpiResid E{X, X, XB, sq2, 1.0f}; pg8::gemm_phase(L, g, S, E);
        }
        SEAM(pb + 8);
        if (EN(10) && IN(pb + 9)) { DEFPTRS; LAYERPTRS;
            { pg8::Gemm g{XB, W + WO_FB1, NTOK, 2 * FF, DM, DM, DM, 0, 0}; pg8::StaticOrder S; S.init(NTOK, 2 * FF, G, bxl);
              pg8::EpiSwiglu E{HB, sq2}; pg8::gemm_phase(L, g, S, E); }
            { pg8::Gemm g{PB, W + WO_PE, NTOK, DM, PLE, PLE, PLE, 0, 0}; pg8::StaticOrder S; S.init(NTOK, DM, G, bxl);
              pg8::EpiBf16<DM> E{YS}; pg8::gemm_phase(L, g, S, E); }
        }
        SEAM(pb + 9);
        if (EN(11) && IN(pb + 10)) { DEFPTRS; LAYERPTRS;
            pg8::Gemm g{HB, W + WO_FB2, NTOK, DM, FF, FF, FF, 0, 0}; pg8::StaticOrder S; S.init(NTOK, DM, G, bxl);
            pg8::EpiResid E{X, X, XB, sq3, 0.5f}; pg8::gemm_phase(L, g, S, E);
        }
        SEAM(pb + 10);
        if (EN(12) && IN(pb + 11)) { DEFPTRS; LAYERPTRS;
            pg8::Gemm g{XB, W + WO_PG, NTOK, DM, DM, DM, DM, 0, 0}; pg8::StaticOrder S; S.init(NTOK, DM, G, bxl);
            pg8::EpiPle E{X, XBA, YS, sq3, sq4}; pg8::gemm_phase(L, g, S, E);
        }
        SEAM(pb + 11);
    }
    if (EN(13) && IN(49)) { DEFPTRS;
        const float* fn = ka->in[19]; const float* sqf = SQ;
        for (int row = gw; row < NTOK; row += NGW) { const float rs = rstd16(sqf, row); f32x4* xr = (f32x4*)(X + (size_t)row * DM) + lane; const f32x4* gr = (const f32x4*)fn + lane;
#pragma unroll
            for (int j = 0; j < 4; ++j) xr[64 * j] = xr[64 * j] * rs * gr[64 * j]; }
    }
#undef IN
#undef SEAM
}

extern "C" void kernel_launch(void* const* d_in, const int* in_sizes, int n_in, void* d_out, int out_size, void* d_ws, size_t ws_size, hipStream_t stream) {
    static int grid = 0;
    if (grid == 0) {
        if (n_in != 20 || out_size != NTOK * DM || ws_size < WS_END) { fprintf(stderr, "kernel_launch: unexpected shapes (n_in %d, out %d, ws %zu)\n", n_in, out_size, ws_size); grid = -1; return; }
        int dev = 0, cus = 0, per_cu = 0;
        if (hipGetDevice(&dev) != hipSuccess || hipDeviceGetAttribute(&cus, hipDeviceAttributeMultiprocessorCount, dev) != hipSuccess) { grid = -1; return; }
        if (hipFuncSetAttribute((const void*)fwd, hipFuncAttributeMaxDynamicSharedMemorySize, LDS_BYTES) != hipSuccess) { fprintf(stderr, "kernel_launch: hipFuncSetAttribute failed\n"); grid = -1; return; }
        if (hipOccupancyMaxActiveBlocksPerMultiprocessor(&per_cu, (const void*)fwd, NWAVES * 64, LDS_BYTES) != hipSuccess || per_cu < 1) { fprintf(stderr, "kernel_launch: occupancy query says %d\n", per_cu); }
        (void)hipGetLastError();
        grid = cus;
    }
    if (grid < 0) return;
    if (hipMemsetAsync((char*)d_ws + WS_CTL, 0, CTL_ZERO_BYTES, stream) != hipSuccess) return;
    KArgs a{};
    for (int i = 0; i < 20; ++i) a.in[i] = (const float*)d_in[i];
    a.out = (float*)d_out; a.ws = (unsigned char*)d_ws; a.pad = 0;
#if MK_PER_PHASE
    for (int ph = 0; ph < N_PHASES; ++ph) { a.ph_lo = ph; a.ph_hi = ph + 1; a.li = ph; hipLaunchKernelGGL(fwd, dim3(grid), dim3(NWAVES * 64), LDS_BYTES, stream, a); }
#else
    a.ph_lo = 0; a.ph_hi = N_PHASES; a.li = 0;
    hipLaunchKernelGGL(fwd, dim3(grid), dim3(NWAVES * 64), LDS_BYTES, stream, a);
#endif
}
```

```cpp
#include <hip/hip_runtime.h>
#include <hip/hip_bf16.h>
#include <cstdio>
#include <cstdint>
#include <cmath>

#define LAS __attribute__((address_space(3)))
#define GAS __attribute__((address_space(1)))
typedef unsigned short bf16_t;
typedef short bf16x8 __attribute__((ext_vector_type(8)));
typedef short s16x4 __attribute__((ext_vector_type(4)));
typedef float f32x4 __attribute__((ext_vector_type(4)));
typedef float f32x2 __attribute__((ext_vector_type(2)));
typedef float f32x16 __attribute__((ext_vector_type(16)));
typedef unsigned u32x4 __attribute__((ext_vector_type(4)));
typedef unsigned u32x2 __attribute__((ext_vector_type(2)));

constexpr int NTOK = 65536, DM = 1024, SEQ = 8192, NBATCH = 8, DEPTH = 4, FF = 2816, PLE = 256;
constexpr int NMIX = 3072, NGATE = 4096, INCOLS = 7076;
constexpr float EPS = 1e-6f, LOG2E = 1.4426950408889634f, LN2 = 0.6931471805599453f;
constexpr int MX_FQ = 0, MX_FK = 256, MX_FV = 512, MX_MCQ = 768, MX_T4 = 1024, MX_SQ = 1280, MX_SK = 1536, MX_SV = 1792, MX_HQ = 2048, MX_HF = 2304, MX_HI = 2560, MX_HG = 2816;

__device__ __forceinline__ unsigned cvt_pk_bf16(float lo, float hi) { typedef __bf16 bf16x2_t __attribute__((ext_vector_type(2))); f32x2 v = {lo, hi}; bf16x2_t b = __builtin_convertvector(v, bf16x2_t); return __builtin_bit_cast(unsigned, b); }
__device__ __forceinline__ unsigned cvt_pk_bf16_v(float lo, float hi) { unsigned r; asm volatile("v_cvt_pk_bf16_f32 %0, %1, %2" : "=v"(r) : "v"(lo), "v"(hi)); return r; }
__device__ __forceinline__ int lane_id() { return (int)__builtin_amdgcn_mbcnt_hi(~0u, __builtin_amdgcn_mbcnt_lo(~0u, 0u)); }
template <int M> __device__ __forceinline__ float lx(float x) { return __uint_as_float((unsigned)__builtin_amdgcn_ds_swizzle((int)__float_as_uint(x), (M << 10) | 0x1F)); }
__device__ __forceinline__ float x32_sum(float x) { auto rr = __builtin_amdgcn_permlane32_swap(__float_as_uint(x), __float_as_uint(x), false, false); return __uint_as_float(rr[0]) + __uint_as_float(rr[1]); }
__device__ __forceinline__ float x32_max(float x) { auto rr = __builtin_amdgcn_permlane32_swap(__float_as_uint(x), __float_as_uint(x), false, false); return fmaxf(__uint_as_float(rr[0]), __uint_as_float(rr[1])); }
__device__ __forceinline__ float x32_other(float x, int hi) { auto rr = __builtin_amdgcn_permlane32_swap(__float_as_uint(x), __float_as_uint(x), false, false); return __uint_as_float(hi ? rr[0] : rr[1]); }
__device__ __forceinline__ u32x4 widen16(u32x2 a, u32x2 b) { auto rx = __builtin_amdgcn_permlane16_swap(a.x, b.x, false, false); auto ry = __builtin_amdgcn_permlane16_swap(a.y, b.y, false, false); return (u32x4){rx[0], ry[0], rx[1], ry[1]}; }
__device__ __forceinline__ float bperm(float x, int src_lane) { return __uint_as_float((unsigned)__builtin_amdgcn_ds_bpermute(src_lane << 2, (int)__float_as_uint(x))); }
__device__ __forceinline__ float wave_sum(float v) { v += lx<1>(v); v += lx<2>(v); v += lx<4>(v); v += lx<8>(v); v += lx<16>(v); return x32_sum(v); }
__device__ __forceinline__ float wave_max(float v) { v = fmaxf(v, lx<1>(v)); v = fmaxf(v, lx<2>(v)); v = fmaxf(v, lx<4>(v)); v = fmaxf(v, lx<8>(v)); v = fmaxf(v, lx<16>(v)); return x32_max(v); }
__device__ __forceinline__ float clamp8(float v) { return __builtin_amdgcn_fmed3f(v, -448.f, 448.f); }
__device__ __forceinline__ unsigned pk_fp8x4(float a, float b, float c, float d) { int p = __builtin_amdgcn_cvt_pk_fp8_f32(clamp8(a), clamp8(b), 0, false); p = __builtin_amdgcn_cvt_pk_fp8_f32(clamp8(c), clamp8(d), p, true); return (unsigned)p; }
__device__ __forceinline__ float bf_lo(unsigned w) { return __uint_as_float(w << 16); }
__device__ __forceinline__ float bf_hi(unsigned w) { return __uint_as_float(w & 0xffff0000u); }
__device__ __forceinline__ float fast_exp2(float x) { return __builtin_amdgcn_exp2f(x); }
__device__ __forceinline__ float fast_log2(float x) { return __builtin_amdgcn_logf(x); }
__device__ __forceinline__ float fast_rcp(float x) { return __builtin_amdgcn_rcpf(x); }
__device__ __forceinline__ float sigmoidf_(float x) { return fast_rcp(1.f + fast_exp2(-x * LOG2E)); }
__device__ __forceinline__ float rstd16(const float* ps, int row) { const f32x4* p = (const f32x4*)(ps + (size_t)row * 16); const f32x4 a = p[0], b = p[1], c = p[2], d = p[3];
    const f32x4 t = (a + b) + (c + d); return __builtin_amdgcn_rsqf(((t[0] + t[1]) + (t[2] + t[3])) * (1.f / 1024.f) + 1e-6f); }
__device__ __forceinline__ float rstd4(const float* ps, int row, float inv_n) { const f32x4 t = *(const f32x4*)(ps + (size_t)row * 4); return __builtin_amdgcn_rsqf(((t[0] + t[1]) + (t[2] + t[3])) * inv_n + 1e-6f); }
__device__ __forceinline__ void rstd16_rows(const float* ps, int row0, float (&rs)[8]) {
#pragma unroll
    for (int h = 0; h < 4; ++h) { f32x4 t[2][4];
#pragma unroll
        for (int m = 0; m < 2; ++m) { const int k = 2 * h + m; const f32x4* p = (const f32x4*)(ps + (size_t)(row0 + (k >> 2) * 128 + (k & 3) * 16) * 16);
#pragma unroll
            for (int j = 0; j < 4; ++j) t[m][j] = p[j]; }
#pragma unroll
        for (int m = 0; m < 2; ++m) { const f32x4 s = (t[m][0] + t[m][1]) + (t[m][2] + t[m][3]); rs[2 * h + m] = __builtin_amdgcn_rsqf(((s[0] + s[1]) + (s[2] + s[3])) * (1.f / 1024.f) + 1e-6f); }
        asm volatile("" : "+v"(row0) : "v"(rs[2 * h]), "v"(rs[2 * h + 1]) : "memory"); }
}
__device__ __forceinline__ void rstd4_rows(const float* ps, int row0, float inv_n, float (&rs)[8]) {
    f32x4 t[8];
#pragma unroll
    for (int k = 0; k < 8; ++k) t[k] = *(const f32x4*)(ps + (size_t)(row0 + (k >> 2) * 128 + (k & 3) * 16) * 4);
#pragma unroll
    for (int k = 0; k < 8; ++k) rs[k] = __builtin_amdgcn_rsqf(((t[k][0] + t[k][1]) + (t[k][2] + t[k][3])) * inv_n + 1e-6f);
}
__device__ __forceinline__ f32x2 sig2_t(f32x2 t) { f32x2 e; e.x = fast_exp2(t.x); e.y = fast_exp2(t.y); const f32x2 d = e + 1.0f; f32x2 r; r.x = fast_rcp(d.x); r.y = fast_rcp(d.y); return r; }
__device__ __forceinline__ float rstd_from(float sumsq, float inv_n) { return __builtin_amdgcn_rsqf(sumsq * inv_n + EPS); }

namespace pg8 {
constexpr int BM = 256, BK = 64, HALF = 128, HTB = HALF * BK * 2  , STAGE_BYTES = 8 * HTB, NXCD = 8, WGM = 8;
__host__ __device__ __forceinline__ int lds_byte(int r, int c) { const int st = (r >> 4) * 2 + (c >> 5), rr = r & 15, cc = c & 31, ob = rr * 64 + cc * 2; return st * 1024 + (ob ^ (((ob >> 9) & 1) << 5)); }
__host__ __device__ __forceinline__ void stage_rc(int b, int& R, int& C) { const int st = b / 1024, sb = b % 1024, swz = sb ^ (((sb >> 9) & 1) << 5); R = (st >> 1) * 16 + swz / 64; C = (st & 1) * 32 + (swz % 64) / 2; }
__host__ __device__ __forceinline__ int perm32(int rho) { const int n = rho >> 4, i = rho & 15; return 8 * (i >> 2) + 4 * n + (i & 3); }

struct Unit { int pm, pn, ord; };
constexpr int RS_TAB_OFF = 131072 + 2048, RS_TAB_UNITS = 24, STG_OFF = RS_TAB_OFF + 4096, STG_WAVE = 3328, STG_PITCH = 144, STG_X8 = 2304;
struct Gemm { const bf16_t* A; const bf16_t* Bt; int M, N, K, lda, ldb, a_shift, a_goff; int sx, sw; };

struct StaticOrder {
    int nM, nN, nwg, G, c, rev;
    __host__ __device__ void init(int M, int N, int G_, int c_, int rev_ = 0) { nM = M / BM; nN = N / BM; nwg = nM * nN; G = G_; c = c_; rev = rev_; }
    __host__ __device__ bool next(int i, Unit& u) const {
        const long L = (long)i * G + c; if (L >= nwg) return false;
        int wgid = (int)L; { const int q = nwg / NXCD, r = nwg % NXCD, xcd = wgid % NXCD, off = wgid / NXCD; wgid = (xcd < r ? xcd * (q + 1) : r * (q + 1) + (xcd - r) * q) + off; }
        const int nig = WGM * nN, gid = wgid / nig, fm = gid * WGM, gsz = (nM - fm) < WGM ? (nM - fm) : WGM;
        u.pm = fm + ((wgid % nig) % gsz); u.pn = (wgid % nig) / gsz; if (rev) u.pm = nM - 1 - u.pm; return true;
    }
};

typedef int v4i_t __attribute__((ext_vector_type(4)));
typedef int v8i_t __attribute__((ext_vector_type(8)));
template <class Epi, bool F8 = false>
__device__ __forceinline__ void gemm_phase(LAS unsigned char* lds, const Gemm g, const StaticOrder& S, const Epi& E, const int wv) {
    int tid_ = (wv << 6) | lane_id(); asm volatile("" : "+v"(tid_));
    const int tid = tid_, wid = __builtin_amdgcn_readfirstlane(tid >> 6), lane = tid & 63, wr = wid >> 2, wc = wid & 3, fr = lane & 15, fq = lane >> 4;
    const int K = g.K, nt = K / BK;
    unsigned voffA[2], voffB[2];
#pragma unroll
    for (int i = 0; i < 2; ++i) { int R, C; stage_rc(tid * 16 + i * 8192, R, C); const int Rb = Epi::CMAP ? (64 * (R >> 5) + perm32(R & 31)) : Epi::PERM ? ((R & ~31) + perm32(R & 31)) : R;
        voffA[i] = (unsigned)(R * g.lda + C) * 2u; voffB[i] = (unsigned)(Rb * g.ldb + C) * 2u; }
    const size_t kstep = (size_t)(BK * 2);
    const size_t hstepA = (size_t)HALF * g.lda * 2, hstepB = (size_t)(Epi::CMAP ? 32 : HALF) * g.ldb * 2;
    const size_t tstepA = 2 * hstepA, tstepB = (size_t)BM * g.ldb * 2;
    const unsigned ldsw = (unsigned)wid * 1024u;
    const int aoff = lds_byte(wr * 64 + fr, fq * 8), boff = lds_byte(wc * 32 + fr, fq * 8);
#define PG8_SA(b, h) (((b) * 2 + (h)) * HTB)
#define PG8_SB(b, h) ((4 + (b) * 2 + (h)) * HTB)
#define PG8_STAGE(bufoff, gbase, voff) do { _Pragma("unroll") for (int _i = 0; _i < 2; ++_i) \
        __builtin_amdgcn_global_load_lds((const unsigned*)((const char*)(gbase) + (voff)[_i]), (LAS unsigned*)(lds + (bufoff) + ldsw + _i * 8192), 16, 0, 0); } while (0)
#define PG8_LDA(dst, b, h) do { _Pragma("unroll") for (int m = 0; m < 4; ++m) _Pragma("unroll") for (int k = 0; k < 2; ++k) dst[m][k] = *(const LAS bf16x8*)(lds + PG8_SA(b, h) + aoff + m * 2048 + k * 1024); } while (0)
#define PG8_LDB(dst, b, h) do { _Pragma("unroll") for (int n = 0; n < 2; ++n) _Pragma("unroll") for (int k = 0; k < 2; ++k) dst[n][k] = *(const LAS bf16x8*)(lds + PG8_SB(b, h) + boff + n * 2048 + k * 1024); } while (0)
#define PG8_CAT(x) __builtin_shufflevector(__builtin_bit_cast(v4i_t, (x)[0]), __builtin_bit_cast(v4i_t, (x)[1]), 0, 1, 2, 3, 4, 5, 6, 7)
#define PG8_MMA(ai, bj, At, Bt) do { __builtin_amdgcn_s_setprio(1); _Pragma("unroll") for (int m = 0; m < 4; ++m) _Pragma("unroll") for (int n = 0; n < 2; ++n) { \
        if (F8) { const v8i_t b8_ = PG8_CAT(Bt[n]), a8_ = PG8_CAT(At[m]); asm volatile("v_mfma_scale_f32_16x16x128_f8f6f4 %0, %1, %2, %0, %3, %4 op_sel_hi:[0,0,0]" : "+v"(acc[ai][bj][m][n]) : "v"(b8_), "v"(a8_), "v"(vsw), "v"(vsx)); } \
        else { _Pragma("unroll") for (int k = 0; k < 2; ++k) acc[ai][bj][m][n] = __builtin_amdgcn_mfma_f32_16x16x32_bf16(Bt[n][k], At[m][k], acc[ai][bj][m][n], 0, 0, 0); } } __builtin_amdgcn_s_setprio(0); } while (0)
#define PG8_WAIT_V(n) asm volatile("s_waitcnt vmcnt(" #n ")" ::: "memory")
#define PG8_WAIT_L(n) asm volatile("s_waitcnt lgkmcnt(" #n ")" ::: "memory")
#define PG8_BAR __builtin_amdgcn_s_barrier()
#define PG8_SCHED __builtin_amdgcn_sched_barrier(0)
    Unit cur, nxt; int ui = 0;
    if (!S.next(0, cur)) return;
    cur.ord = 0;
    if constexpr (Epi::NEEDS_RS) {
        LAS float* tab = (LAS float*)(lds + RS_TAB_OFF); Unit uu;
        for (int i = 0; i < RS_TAB_UNITS && S.next(i, uu); ++i) { const int row = tid >> 1, hf = tid & 1;
            const f32x4* p = (const f32x4*)(E.rs_src() + (size_t)(uu.pm * BM + row) * 16 + 8 * hf); const f32x4 a = p[0], b = p[1]; const f32x4 t = a + b;
            float s = (t[0] + t[1]) + (t[2] + t[3]); s += lx<1>(s);
            if (hf == 0) tab[i * 256 + row] = __builtin_amdgcn_rsqf(s * (1.f / 1024.f) + 1e-6f); }
        asm volatile("s_waitcnt vmcnt(0) lgkmcnt(0)" ::: "memory"); __builtin_amdgcn_s_barrier();
    }
    f32x4 acc[2][2][4][2];
#pragma unroll
    for (int a = 0; a < 2; ++a)
#pragma unroll
        for (int b = 0; b < 2; ++b)
#pragma unroll
            for (int m = 0; m < 4; ++m)
#pragma unroll
                for (int n = 0; n < 2; ++n) acc[a][b][m][n] = (f32x4){0.f, 0.f, 0.f, 0.f};
    bf16x8 At[4][2], B0[2][2], B1[2][2];
    const int vsw = g.sw, vsx = g.sx; (void)vsw; (void)vsx;
    const char* cA = (const char*)g.A + (size_t)cur.pm * tstepA + (size_t)((cur.pn >> g.a_shift) * g.a_goff) * 2; const char* cB = (const char*)g.Bt + (size_t)cur.pn * tstepB;
    PG8_STAGE(PG8_SB(0, 0), cB, voffB); PG8_STAGE(PG8_SB(0, 1), cB + hstepB, voffB); PG8_STAGE(PG8_SA(0, 0), cA, voffA); PG8_STAGE(PG8_SA(0, 1), cA + hstepA, voffA);
    if (wr == 1) PG8_BAR;
    PG8_WAIT_V(2); PG8_BAR;
    PG8_STAGE(PG8_SB(1, 0), cB + kstep, voffB); PG8_STAGE(PG8_SA(1, 0), cA + kstep, voffA); PG8_STAGE(PG8_SB(1, 1), cB + hstepB + kstep, voffB);
    PG8_WAIT_V(6); PG8_BAR;
    for (;;) {
        const bool has_next = S.next(ui + 1, nxt);
        const char* nA = has_next ? (const char*)g.A + (size_t)nxt.pm * tstepA + (size_t)((nxt.pn >> g.a_shift) * g.a_goff) * 2 : cA; const char* nB = has_next ? (const char*)g.Bt + (size_t)nxt.pn * tstepB : cB;
#pragma unroll 1
        for (int t = 0; t < nt; t += 2) {
            const bool last = (t == nt - 2);
            const char* a1 = cA + (size_t)(t + 1) * kstep;
            const char* a2 = last ? nA : cA + (size_t)(t + 2) * kstep; const char* b2 = last ? nB : cB + (size_t)(t + 2) * kstep;
            const char* a3 = a2 + kstep; const char* b3 = b2 + kstep;
            PG8_LDB(B0, 0, 0); PG8_LDB(B1, 0, 1); PG8_SCHED; PG8_LDA(At, 0, 0); PG8_STAGE(PG8_SA(1, 1), a1 + hstepA, voffA);
            PG8_WAIT_V(8); PG8_WAIT_L(0); PG8_BAR; PG8_MMA(0, 0, At, B0); PG8_MMA(0, 1, At, B1); PG8_BAR; PG8_SCHED;
            PG8_LDA(At, 0, 1); PG8_STAGE(PG8_SB(0, 0), b2, voffB); PG8_STAGE(PG8_SB(0, 1), b2 + hstepB, voffB); PG8_STAGE(PG8_SA(0, 0), a2, voffA);
            PG8_WAIT_V(8); PG8_WAIT_L(0); PG8_BAR; PG8_MMA(1, 0, At, B0); PG8_MMA(1, 1, At, B1); PG8_BAR; PG8_SCHED;
            PG8_LDB(B0, 1, 0); PG8_LDB(B1, 1, 1); PG8_SCHED; PG8_LDA(At, 1, 0); PG8_STAGE(PG8_SA(0, 1), a2 + hstepA, voffA);
            PG8_WAIT_V(8); PG8_WAIT_L(0); PG8_BAR; PG8_MMA(0, 0, At, B0); PG8_MMA(0, 1, At, B1); PG8_BAR; PG8_SCHED;
            PG8_LDA(At, 1, 1); PG8_STAGE(PG8_SB(1, 0), b3, voffB); PG8_STAGE(PG8_SB(1, 1), b3 + hstepB, voffB); PG8_STAGE(PG8_SA(1, 0), a3, voffA);
            PG8_WAIT_V(8); PG8_WAIT_L(0); PG8_BAR; PG8_MMA(1, 0, At, B0); PG8_MMA(1, 1, At, B1); PG8_BAR; PG8_SCHED;
        }
        if (wr == 0) PG8_BAR;
        if (F8) asm volatile("s_nop 15\n\ts_nop 15" ::: "memory");
        E(acc, cur, wr, wc, fr, fq);
        if (!has_next) break;
#pragma unroll
        for (int a = 0; a < 2; ++a)
#pragma unroll
            for (int b = 0; b < 2; ++b)
#pragma unroll
                for (int m = 0; m < 4; ++m)
#pragma unroll
                    for (int n = 0; n < 2; ++n) acc[a][b][m][n] = (f32x4){0.f, 0.f, 0.f, 0.f};
        cur = nxt; cA = nA; cB = nB; ++ui; cur.ord = ui;
        if (wr == 1) PG8_BAR;
    }
    PG8_WAIT_V(0);
    PG8_BAR;
#undef PG8_SA
#undef PG8_SB
#undef PG8_STAGE
#undef PG8_LDA
#undef PG8_LDB
#undef PG8_MMA
#undef PG8_CAT
#undef PG8_WAIT_V
#undef PG8_WAIT_L
#undef PG8_BAR
#undef PG8_SCHED
}

#define EPI_ARGS const f32x4 (&acc)[2][2][4][2], const Unit& u, int wr, int wc, int fr, int fq
template <int ldc> struct EpiBf16 {
    static constexpr bool PERM = true; static constexpr bool NEEDS_RS = false; static constexpr bool CMAP = false;
    bf16_t* O;
    __device__ __forceinline__ void operator()(EPI_ARGS) const {
        asm volatile("" : "+v"(fr), "+v"(fq));
        const int row0 = u.pm * BM + wr * 64 + fr, col0 = u.pn * BM + wc * 32 + 8 * fq;
#pragma unroll
        for (int ai = 0; ai < 2; ++ai)
#pragma unroll
            for (int m = 0; m < 4; ++m) { bf16_t* rowp = O + (size_t)(row0 + ai * HALF + m * 16) * ldc + col0;
#pragma unroll
                for (int bj = 0; bj < 2; ++bj) { const f32x4 v0 = acc[ai][bj][m][0], v1 = acc[ai][bj][m][1];
                    u32x4 w; w.x = cvt_pk_bf16_v(v0[0], v0[1]); w.y = cvt_pk_bf16_v(v0[2], v0[3]); w.z = cvt_pk_bf16_v(v1[0], v1[1]); w.w = cvt_pk_bf16_v(v1[2], v1[3]);
                    *(u32x4*)(rowp + bj * HALF) = w; } }
    }
};
struct EpiSwiglu {
    static constexpr bool PERM = true; static constexpr bool NEEDS_RS = true; static constexpr bool CMAP = false;
    unsigned char* H8; const float* sq; LAS const float* rstab;
    __device__ __forceinline__ const float* rs_src() const { return sq; }
    __device__ __forceinline__ void operator()(EPI_ARGS) const {
        asm volatile("" : "+v"(fr), "+v"(fq));
        const int row0 = u.pm * BM + wr * 64 + fr, col0 = u.pn * HALF + wc * 32 + 8 * fq;
        float rsv[8];
#pragma unroll
        for (int k = 0; k < 8; ++k) rsv[k] = rstab[u.ord * 256 + (k >> 2) * 128 + wr * 64 + (k & 3) * 16 + fr];
#pragma unroll
        for (int ai = 0; ai < 2; ++ai)
#pragma unroll
            for (int mp = 0; mp < 2; ++mp) { u32x2 w2[2];
#pragma unroll
                for (int mm = 0; mm < 2; ++mm) { const int m = 2 * mp + mm; const float rs = rsv[ai * 4 + m];
                    float h[8]; const float c1 = -rs * LOG2E, k2 = 8.f * rs * rs;
#pragma unroll
                    for (int n = 0; n < 2; ++n)
#pragma unroll
                        for (int i = 0; i < 4; i += 2) { const f32x2 ag = {acc[ai][0][m][n][i], acc[ai][0][m][n][i + 1]}, au = {acc[ai][1][m][n][i], acc[ai][1][m][n][i + 1]};
                            const f32x2 r = sig2_t(ag * c1); const f32x2 hv = ((ag * au) * k2) * r; h[4 * n + i] = hv.x; h[4 * n + i + 1] = hv.y; }
                    w2[mm].x = pk_fp8x4(h[0], h[1], h[2], h[3]); w2[mm].y = pk_fp8x4(h[4], h[5], h[6], h[7]); }
                const u32x4 w = widen16(w2[0], w2[1]);
                const int row = row0 + ai * HALF + (2 * mp + (fq & 1)) * 16;
                *(u32x4*)(H8 + (size_t)row * FF + col0 - 8 * (fq & 1)) = w; }
    }
};
__device__ __forceinline__ void unpack8(const u32x4 w, float (&f)[8]) { f[0] = bf_lo(w.x); f[1] = bf_hi(w.x); f[2] = bf_lo(w.y); f[3] = bf_hi(w.y); f[4] = bf_lo(w.z); f[5] = bf_hi(w.z); f[6] = bf_lo(w.w); f[7] = bf_hi(w.w); }
struct EpiResid {
    static constexpr bool PERM = true; static constexpr bool NEEDS_RS = false; static constexpr bool CMAP = true;
    const bf16_t* base; bf16_t* xo; float* sq; float alpha; unsigned char* x8; LAS unsigned char* stg;
    __device__ __forceinline__ void operator()(EPI_ARGS) const {
        asm volatile("" : "+v"(fr), "+v"(fq));
        const int lane = fr + 16 * fq;
        const int row0 = u.pm * BM + wr * 64 + fr, col0 = u.pn * BM + wc * 64 + 8 * fq, colw = u.pn * BM + wc * 64;
        LAS unsigned char* sx = stg + (wr * 4 + wc) * STG_WAVE; LAS unsigned char* s8 = sx + STG_X8;
        int row0l = row0;
#pragma unroll
        for (int ai = 0; ai < 2; ++ai) {
            u32x4 old[4][2];
#pragma unroll
            for (int m = 0; m < 4; ++m)
#pragma unroll
                for (int bj = 0; bj < 2; ++bj) old[m][bj] = *(const u32x4*)(base + (size_t)(row0l + ai * HALF + m * 16) * DM + col0 + bj * 32);
            float ssm[4];
#pragma unroll
            for (int m = 0; m < 4; ++m) { const int rb = u.pm * BM + ai * HALF + wr * 64 + m * 16; float ss = 0.f;
#pragma unroll
                for (int bj = 0; bj < 2; ++bj) {
                    float b[8]; unpack8(old[m][bj], b);
                    const f32x4 a0 = acc[ai][bj][m][0], a1 = acc[ai][bj][m][1];
                    float r[8];
#pragma unroll
                    for (int i = 0; i < 4; ++i) { r[i] = b[i] + alpha * a0[i]; r[4 + i] = b[4 + i] + alpha * a1[i]; }
                    u32x4 w; w.x = cvt_pk_bf16_v(r[0], r[1]); w.y = cvt_pk_bf16_v(r[2], r[3]); w.z = cvt_pk_bf16_v(r[4], r[5]); w.w = cvt_pk_bf16_v(r[6], r[7]);
                    *(LAS u32x4*)(sx + fr * STG_PITCH + (4 * bj + fq) * 16) = w;
                    if (x8) { u32x2 z; z.x = pk_fp8x4(r[0], r[1], r[2], r[3]); z.y = pk_fp8x4(r[4], r[5], r[6], r[7]); *(LAS u32x2*)(s8 + fr * 64 + (4 * bj + fq) * 8) = z; }
                    ss += ((r[0] * r[0] + r[1] * r[1]) + (r[2] * r[2] + r[3] * r[3])) + ((r[4] * r[4] + r[5] * r[5]) + (r[6] * r[6] + r[7] * r[7])); }
                ss += lx<16>(ss); ssm[m] = x32_sum(ss);
                asm volatile("s_waitcnt lgkmcnt(0)" ::: "memory");
#pragma unroll
                for (int k = 0; k < 2; ++k) { const int r = 8 * k + (lane >> 3), c = lane & 7; const u32x4 v = *(LAS const u32x4*)(sx + r * STG_PITCH + c * 16); *(u32x4*)(xo + (size_t)(rb + r) * DM + colw + c * 8) = v; }
                if (x8) { const int r = lane >> 2, c = lane & 3; const u32x4 v = *(LAS const u32x4*)(s8 + r * 64 + c * 16); *(u32x4*)(x8 + (size_t)(rb + r) * DM + colw + c * 16) = v; }
            }
            { const float sel = (fq == 0) ? ssm[0] : (fq == 1) ? ssm[1] : (fq == 2) ? ssm[2] : ssm[3];
              sq[(size_t)(row0 + ai * HALF + fq * 16) * 16 + u.pn * 4 + wc] = sel; }
            asm volatile("" : "+v"(row0l) :: "memory");
        }
    }
};
struct EpiPle {
    static constexpr bool PERM = true; static constexpr bool NEEDS_RS = true; static constexpr bool CMAP = true;
    const bf16_t* xi; bf16_t* xo; const bf16_t* Eb; const float* sq_in; float* sq_out; unsigned char* x8; LAS const float* rstab; LAS unsigned char* stg;
    __device__ __forceinline__ const float* rs_src() const { return sq_in; }
    __device__ __forceinline__ void operator()(EPI_ARGS) const {
        asm volatile("" : "+v"(fr), "+v"(fq));
        const int lane = fr + 16 * fq;
        const int row0 = u.pm * BM + wr * 64 + fr, col0 = u.pn * BM + wc * 64 + 8 * fq, colw = u.pn * BM + wc * 64;
        LAS unsigned char* sx = stg + (wr * 4 + wc) * STG_WAVE; LAS unsigned char* s8 = sx + STG_X8;
        float rsv[8];
#pragma unroll
        for (int k = 0; k < 8; ++k) rsv[k] = rstab[u.ord * 256 + (k >> 2) * 128 + wr * 64 + (k & 3) * 16 + fr];
        int row0l = row0; asm volatile("" : "+v"(row0l) : "v"(rsv[7]));
#pragma unroll
        for (int hq = 0; hq < 4; ++hq) {
            const int ai = hq >> 1;
            u32x4 ox[2][2], oe[2][2];
#pragma unroll
            for (int mm = 0; mm < 2; ++mm)
#pragma unroll
                for (int bj = 0; bj < 2; ++bj) { const size_t off = (size_t)(row0l + ai * HALF + (2 * (hq & 1) + mm) * 16) * DM + col0 + bj * 32; ox[mm][bj] = *(const u32x4*)(xi + off); oe[mm][bj] = *(const u32x4*)(Eb + off); }
            float ssm[2];
#pragma unroll
            for (int mm = 0; mm < 2; ++mm) { const int m = 2 * (hq & 1) + mm; const int rb = u.pm * BM + ai * HALF + wr * 64 + m * 16; float ss = 0.f; const float rs = rsv[ai * 4 + m];
#pragma unroll
                for (int bj = 0; bj < 2; ++bj) {
                    float b[8], e[8]; unpack8(ox[mm][bj], b); unpack8(oe[mm][bj], e);
                    const f32x4 a0 = acc[ai][bj][m][0], a1 = acc[ai][bj][m][1]; const float c1 = -rs * LOG2E;
                    const f32x2 g0 = sig2_t((f32x2){a0[0], a0[1]} * c1), g1 = sig2_t((f32x2){a0[2], a0[3]} * c1), g2 = sig2_t((f32x2){a1[0], a1[1]} * c1), g3 = sig2_t((f32x2){a1[2], a1[3]} * c1);
                    const f32x2 y0 = (f32x2){b[0], b[1]} + g0 * (f32x2){e[0], e[1]}, y1 = (f32x2){b[2], b[3]} + g1 * (f32x2){e[2], e[3]}, y2 = (f32x2){b[4], b[5]} + g2 * (f32x2){e[4], e[5]}, y3 = (f32x2){b[6], b[7]} + g3 * (f32x2){e[6], e[7]};
                    u32x4 w; w.x = cvt_pk_bf16_v(y0.x, y0.y); w.y = cvt_pk_bf16_v(y1.x, y1.y); w.z = cvt_pk_bf16_v(y2.x, y2.y); w.w = cvt_pk_bf16_v(y3.x, y3.y);
                    *(LAS u32x4*)(sx + fr * STG_PITCH + (4 * bj + fq) * 16) = w; const float r[8] = {y0.x, y0.y, y1.x, y1.y, y2.x, y2.y, y3.x, y3.y};
                    { u32x2 z; z.x = pk_fp8x4(r[0], r[1], r[2], r[3]); z.y = pk_fp8x4(r[4], r[5], r[6], r[7]); *(LAS u32x2*)(s8 + fr * 64 + (4 * bj + fq) * 8) = z; }
                    ss += ((r[0] * r[0] + r[1] * r[1]) + (r[2] * r[2] + r[3] * r[3])) + ((r[4] * r[4] + r[5] * r[5]) + (r[6] * r[6] + r[7] * r[7])); }
                ss += lx<16>(ss); ssm[mm] = x32_sum(ss);
                asm volatile("s_waitcnt lgkmcnt(0)" ::: "memory");
#pragma unroll
                for (int k = 0; k < 2; ++k) { const int r = 8 * k + (lane >> 3), c = lane & 7; const u32x4 v = *(LAS const u32x4*)(sx + r * STG_PITCH + c * 16); *(u32x4*)(xo + (size_t)(rb + r) * DM + colw + c * 8) = v; }
                { const int r = lane >> 2, c = lane & 3; const u32x4 v = *(LAS const u32x4*)(s8 + r * 64 + c * 16); *(u32x4*)(x8 + (size_t)(rb + r) * DM + colw + c * 16) = v; }
            }
            if (fq < 2) sq_out[(size_t)(row0 + ai * HALF + (2 * (hq & 1) + fq) * 16) * 16 + u.pn * 4 + wc] = (fq == 0) ? ssm[0] : ssm[1];
            asm volatile("" : "+v"(row0l) :: "memory");
        }
    }
};
struct EpiPnat {
    static constexpr bool PERM = false; static constexpr bool NEEDS_RS = false; static constexpr bool CMAP = false;
    unsigned* Pn;
    __device__ __forceinline__ void operator()(EPI_ARGS) const {
        asm volatile("" : "+v"(fr), "+v"(fq));
        const int nb = u.pn >> 2, lane = fr + 16 * fq;
#pragma unroll
        for (int ai = 0; ai < 2; ++ai)
#pragma unroll
            for (int bj = 0; bj < 2; ++bj)
#pragma unroll
                for (int n = 0; n < 2; ++n) { const int png = 4 * (u.pn & 3) + 2 * bj + (wc >> 1), wcg = 2 * (wc & 1) + n; u32x4 o;
#pragma unroll
                    for (int m = 0; m < 4; ++m) { const f32x4 a = acc[ai][bj][m][n] * 4.f; o[m] = pk_fp8x4(a[0], a[1], a[2], a[3]); }
                    *(u32x4*)(Pn + ((((((size_t)u.pm * 16 + png) * 8 + wr * 4 + wcg) * 2 + ai) * 4 + nb) * 64 + lane) * 4) = o; }
    }
};
struct EpiGate {
    static constexpr bool PERM = false; static constexpr bool NEEDS_RS = true; static constexpr bool CMAP = false;
    unsigned char* MB; const unsigned* Pn; const float* sq; LAS const float* rstab;
    __device__ __forceinline__ const float* rs_src() const { return sq; }
    __device__ __forceinline__ void operator()(EPI_ARGS) const {
        asm volatile("" : "+v"(fr), "+v"(fq));
        const int row0 = u.pm * BM + wr * 64 + fr, col0 = u.pn * 64 + wc * 16 + 4 * fq, lane = fr + 16 * fq;
        float rsv[8];
#pragma unroll
        for (int k = 0; k < 8; ++k) rsv[k] = rstab[u.ord * 256 + (k >> 2) * 128 + wr * 64 + (k & 3) * 16 + fr];
#pragma unroll
        for (int ai = 0; ai < 2; ++ai) {
            unsigned pv[4][4];
#pragma unroll
            for (int nb = 0; nb < 4; ++nb) { const u32x4 t = *(const u32x4*)(Pn + ((((((size_t)u.pm * 16 + u.pn) * 8 + wr * 4 + wc) * 2 + ai) * 4 + nb) * 64 + lane) * 4);
#pragma unroll
                for (int m = 0; m < 4; ++m) pv[m][nb] = t[m]; }
            unsigned wm[4];
#pragma unroll
            for (int m = 0; m < 4; ++m) { const float rs = rsv[ai * 4 + m];
                f32x2 s01 = {0.f, 0.f}, s23 = {0.f, 0.f}; const float c1 = -rs * LOG2E;
#pragma unroll
                for (int bj = 0; bj < 2; ++bj)
#pragma unroll
                    for (int n = 0; n < 2; ++n) { const int p4 = (int)pv[m][2 * bj + n]; const f32x4 a = acc[ai][bj][m][n];
                        const f32x2 r0 = sig2_t((f32x2){a[0], a[1]} * c1), r1 = sig2_t((f32x2){a[2], a[3]} * c1);
                        const f32x2 q0 = __builtin_amdgcn_cvt_pk_f32_fp8(p4, false), q1 = __builtin_amdgcn_cvt_pk_f32_fp8(p4, true);
                        s01 += r0 * q0; s23 += r1 * q1; }
                wm[m] = pk_fp8x4(s01.x * 2.f, s01.y * 2.f, s23.x * 2.f, s23.y * 2.f); }
            { auto a = __builtin_amdgcn_permlane16_swap(wm[0], wm[1], false, false); wm[0] = a[0]; wm[1] = a[1]; auto b = __builtin_amdgcn_permlane16_swap(wm[2], wm[3], false, false); wm[2] = b[0]; wm[3] = b[1];
              auto c = __builtin_amdgcn_permlane32_swap(wm[0], wm[2], false, false); wm[0] = c[0]; wm[2] = c[1]; auto d = __builtin_amdgcn_permlane32_swap(wm[1], wm[3], false, false); wm[1] = d[0]; wm[3] = d[1]; }
            *(u32x4*)(MB + (size_t)(row0 + ai * HALF + fq * 16) * DM + u.pn * 64 + wc * 16) = (u32x4){wm[0], wm[1], wm[2], wm[3]};
        }
    }
};
struct EpiMix {
    static constexpr bool PERM = true; static constexpr bool NEEDS_RS = true; static constexpr bool CMAP = false;
    bf16_t* MIX; const float* sq; float* sqq; float* sqkv; bf16_t* KR; float* LF; const float* ropec; const float* ropes; const float* bf; float* K2P; LAS const float* rstab;
    __device__ __forceinline__ const float* rs_src() const { return sq; }
    __device__ __forceinline__ void operator()(EPI_ARGS) const {
        asm volatile("" : "+v"(fr), "+v"(fq));
        const int row0 = u.pm * BM + wr * 64 + fr, col0 = u.pn * BM + wc * 32 + 8 * fq;
        const bool special = (u.pn == 1) || (u.pn == 3) || (u.pn == 4);
        float rsv[8];
#pragma unroll
        for (int k = 0; k < 8; ++k) rsv[k] = rstab[u.ord * 256 + (k >> 2) * 128 + wr * 64 + (k & 3) * 16 + fr];
#pragma unroll
        for (int ai = 0; ai < 2; ++ai)
#pragma unroll
            for (int m = 0; m < 4; ++m) { const int row = row0 + ai * HALF + m * 16; const float rs = rsv[ai * 4 + m];
                u32x4 w[2];
#pragma unroll
                for (int bj = 0; bj < 2; ++bj) { const f32x4 a0 = acc[ai][bj][m][0] * rs, a1 = acc[ai][bj][m][1] * rs;
                    w[bj].x = cvt_pk_bf16_v(a0[0], a0[1]); w[bj].y = cvt_pk_bf16_v(a0[2], a0[3]); w[bj].z = cvt_pk_bf16_v(a1[0], a1[1]); w[bj].w = cvt_pk_bf16_v(a1[2], a1[3]);
                    *(u32x4*)(MIX + (size_t)row * NMIX + col0 + bj * HALF) = w[bj]; }
                if (special) {
                    float q2[2];
#pragma unroll
                    for (int bj = 0; bj < 2; ++bj) { float r[8]; unpack8(w[bj], r); float q = ((r[0] * r[0] + r[1] * r[1]) + (r[2] * r[2] + r[3] * r[3])) + ((r[4] * r[4] + r[5] * r[5]) + (r[6] * r[6] + r[7] * r[7]));
                        q += lx<16>(q); q2[bj] = x32_sum(q); }
                    if (u.pn == 1) { if (fq == 0) { K2P[(size_t)row * 8 + (wc >> 1) * 2 + (wc & 1)] = q2[0]; K2P[(size_t)row * 8 + (2 + (wc >> 1)) * 2 + (wc & 1)] = q2[1]; } }
                    if (u.pn == 3) { if (fq == 0) sqq[(size_t)row * 4 + wc] = q2[0] + q2[1]; }
                    if (u.pn == 4) { if (fq == 0) sqkv[(size_t)row * 4 + wc] = q2[0];
                        if (wc == 0) {
                            const int pos = row & (SEQ - 1); const f32x4 c = *(const f32x4*)(ropec + pos * 16 + 4 * fq), s = *(const f32x4*)(ropes + pos * 16 + 4 * fq);
                            const f32x4 x1 = acc[ai][1][m][0] * rs, x2 = acc[ai][1][m][1] * rs; const f32x4 o1 = x1 * c - x2 * s, o2 = x2 * c + x1 * s;
                            u32x2 w1, w2; w1.x = cvt_pk_bf16_v(o1[0], o1[1]); w1.y = cvt_pk_bf16_v(o1[2], o1[3]); w2.x = cvt_pk_bf16_v(o2[0], o2[1]); w2.y = cvt_pk_bf16_v(o2[2], o2[3]);
                            *(u32x2*)(KR + (size_t)row * 32 + 4 * fq) = w1; *(u32x2*)(KR + (size_t)row * 32 + 16 + 4 * fq) = w2; }
                        if (wc == 1 && fq == 0) {
                            const f32x4 vv = acc[ai][1][m][0] * rs; f32x4 o;
#pragma unroll
                            for (int i = 0; i < 4; ++i) { const float z = vv[i] + bf[i]; o[i] = -(fmaxf(-z, 0.f) + LN2 * fast_log2(1.f + fast_exp2(-fabsf(z) * LOG2E))); }
                            *(f32x4*)(LF + (size_t)row * 4) = o; } }
                }
            }
    }
};
struct EpiQup {
    static constexpr bool PERM = true; static constexpr bool NEEDS_RS = false; static constexpr bool CMAP = false;
    bf16_t* QM; const float* sqq; const float* ropec; const float* ropes;
    __device__ __forceinline__ void operator()(EPI_ARGS) const {
        asm volatile("" : "+v"(fr), "+v"(fq));
        const int row0 = u.pm * BM + wr * 64 + fr;
        float rsv[8]; rstd4_rows(sqq, row0, 1.f / 256.f, rsv);
#pragma unroll
        for (int ai = 0; ai < 2; ++ai)
#pragma unroll
            for (int m = 0; m < 4; ++m) { const int row = row0 + ai * HALF + m * 16; const float rs = rsv[ai * 4 + m]; bf16_t* qrow = QM + (size_t)row * 384;
                if (u.pn == 0) {
#pragma unroll
                    for (int bj = 0; bj < 2; ++bj) { const f32x4 a0 = acc[ai][bj][m][0] * rs, a1 = acc[ai][bj][m][1] * rs; const int head = 2 * bj + (wc >> 1), d = 32 * (wc & 1) + 8 * fq;
                        u32x4 w; w.x = cvt_pk_bf16_v(a0[0], a0[1]); w.y = cvt_pk_bf16_v(a0[2], a0[3]); w.z = cvt_pk_bf16_v(a1[0], a1[1]); w.w = cvt_pk_bf16_v(a1[2], a1[3]); *(u32x4*)(qrow + 96 * head + d) = w; }
                } else {
                    const int pos = row & (SEQ - 1); const f32x4 c = *(const f32x4*)(ropec + pos * 16 + 4 * fq), s = *(const f32x4*)(ropes + pos * 16 + 4 * fq);
                    const f32x4 x1 = acc[ai][0][m][0] * rs, x2 = acc[ai][0][m][1] * rs; const f32x4 o1 = x1 * c - x2 * s, o2 = x2 * c + x1 * s;
                    u32x2 w1, w2; w1.x = cvt_pk_bf16_v(o1[0], o1[1]); w1.y = cvt_pk_bf16_v(o1[2], o1[3]); w2.x = cvt_pk_bf16_v(o2[0], o2[1]); w2.y = cvt_pk_bf16_v(o2[2], o2[3]);
                    *(u32x2*)(qrow + 96 * wc + 64 + 4 * fq) = w1; *(u32x2*)(qrow + 96 * wc + 80 + 4 * fq) = w2; }
                asm volatile("" ::: "memory");
            }
    }
};
struct EpiKVup {
    static constexpr bool PERM = true; static constexpr bool NEEDS_RS = false; static constexpr bool CMAP = false;
    bf16_t* KN; bf16_t* VM; const float* sqkv;
    __device__ __forceinline__ void operator()(EPI_ARGS) const {
        asm volatile("" : "+v"(fr), "+v"(fq));
        const int row0 = u.pm * BM + wr * 64 + fr;
        float rsv[8]; rstd4_rows(sqkv, row0, 1.f / 128.f, rsv);
#pragma unroll
        for (int ai = 0; ai < 2; ++ai)
#pragma unroll
            for (int m = 0; m < 4; ++m) { const int row = row0 + ai * HALF + m * 16; const float rs = rsv[ai * 4 + m];
#pragma unroll
                for (int bj = 0; bj < 2; ++bj) { const f32x4 a0 = acc[ai][bj][m][0] * rs, a1 = acc[ai][bj][m][1] * rs; const int head = 2 * u.pn + bj, col = 32 * (wc & 1) + 8 * fq;
                    u32x4 w; w.x = cvt_pk_bf16_v(a0[0], a0[1]); w.y = cvt_pk_bf16_v(a0[2], a0[3]); w.z = cvt_pk_bf16_v(a1[0], a1[1]); w.w = cvt_pk_bf16_v(a1[2], a1[3]);
                    bf16_t* dst = (wc < 2 ? KN : VM) + (size_t)row * 256 + 64 * head + col; *(u32x4*)dst = w; }
                asm volatile("" ::: "memory");
            }
    }
};
struct EpiQKVup {
    static constexpr bool PERM = true; static constexpr bool NEEDS_RS = false; static constexpr bool CMAP = false;
    EpiQup q; EpiKVup kv;
    __device__ __forceinline__ void operator()(EPI_ARGS) const {
        if (u.pn < 2) q(acc, u, wr, wc, fr, fq); else { Unit u2 = u; u2.pn = u.pn - 2; kv(acc, u2, wr, wc, fr, fq); }
    }
};
}

constexpr size_t MiB = 1u << 20;
constexpr size_t WS_CTL = 0, CTL_ZERO_BYTES = 1 * MiB;
constexpr size_t WS_SQ = 1 * MiB;
constexpr size_t WS_ROPE = 19 * MiB;
constexpr size_t WS_LF = 20 * MiB;
constexpr size_t WS_KX = 21 * MiB;
constexpr size_t WS_TB = 25 * MiB;
constexpr size_t WS_K2P = 26 * MiB;
constexpr size_t WS_HGS = 28 * MiB;
constexpr size_t WS_W = 45 * MiB;
constexpr size_t WS_PB = 101 * MiB;
constexpr size_t WS_XB = 133 * MiB;
constexpr size_t WS_YS = 261 * MiB;
constexpr size_t WS_BIG = 389 * MiB;
constexpr size_t WS_X8 = 901 * MiB, WS_END = 965 * MiB;
constexpr size_t BIG_MIX = 0, BIG_QM = 384 * MiB, BIG_KN = 432 * MiB, BIG_VM = 464 * MiB, BIG_KR = 496 * MiB;
constexpr size_t WO_FA1 = 0, WO_FA2 = WO_FA1 + (size_t)5632 * 1024, WO_FB1 = WO_FA2 + (size_t)1024 * 2816, WO_FB2 = WO_FB1 + (size_t)5632 * 1024, WO_MIX = WO_FB2 + (size_t)1024 * 2816,
    WO_GATE = WO_MIX + (size_t)3072 * 1024, WO_UQ = WO_GATE + (size_t)4096 * 1024, WO_UKV = WO_UQ + (size_t)512 * 256, WO_BR = WO_UKV + (size_t)512 * 256, WO_OUT = WO_BR + (size_t)4096 * 256,
    WO_PG = WO_OUT + (size_t)1024 * 1024, WO_PE = WO_PG + (size_t)1024 * 1024, WO_END = WO_PE + (size_t)1024 * 256;
static_assert(WO_END * 2 <= 56 * MiB, "weight copies fit");
constexpr int CW_BAR = 4096;

constexpr int RING_BYTES = 131072, LDSCTL_OFF = RING_BYTES, MISC_OFF = LDSCTL_OFF + 320, LDS_BYTES = 163840;
static_assert(pg8::RS_TAB_OFF >= MISC_OFF + 256 && pg8::RS_TAB_OFF + pg8::RS_TAB_UNITS * 1024 <= LDS_BYTES && pg8::STG_OFF + 8 * pg8::STG_WAVE <= LDS_BYTES, "LDS map");
constexpr int NWAVES = 8;

#define RLX_AGENT __ATOMIC_RELAXED, __HIP_MEMORY_SCOPE_AGENT
#define LDS_WAIT() asm volatile("s_waitcnt lgkmcnt(0)" ::: "memory")
#define VM_WAIT() asm volatile("s_waitcnt vmcnt(0)" ::: "memory")

#define XB_TMO      128
#define XB_XCNT(j)  (256  + 64 * (j))
#define XB_XSUB(j)  (1280 + 64 * (j))
#define XB_XGEN(j)  (2304 + 64 * (j))
#define XB_TOP      3328
#define XB_TOPGEN   3392
#define XCD_BAR_WORDS 3456
#define XB_SPIN_CAP (1u << 20)
__device__ __forceinline__ unsigned xb_ld(unsigned* p)              { return __hip_atomic_load(p, __ATOMIC_RELAXED, __HIP_MEMORY_SCOPE_AGENT); }
__device__ __forceinline__ unsigned xb_add(unsigned* p, unsigned v) { return __hip_atomic_fetch_add(p, v, __ATOMIC_RELAXED, __HIP_MEMORY_SCOPE_AGENT); }
__device__ __forceinline__ unsigned xb_xcc_id() { return (unsigned)__builtin_amdgcn_s_getreg((3 << 11) | 20) & 0xFu; }
#define XB_SPIN(cond, bar) do { unsigned _sp = 0; while (cond) { __builtin_amdgcn_s_sleep(1); \
    if ((++_sp & 255u) == 0u) { if (xb_ld(&(bar)[XB_TMO])) break; if (_sp > XB_SPIN_CAP) { atomicAdd(&(bar)[XB_TMO], 1u); break; } } } } while (0)
struct XcdBarrier { unsigned* bar; unsigned x; volatile LAS unsigned* st; };
__device__ __forceinline__ XcdBarrier xcd_barrier_post(unsigned* bar, volatile LAS unsigned* st, const bool leader) {
    XcdBarrier b; b.bar = bar; b.x = xb_xcc_id(); b.st = st;
    if (leader) (void)xb_add(&bar[XB_XCNT(b.x)], 1u);
    return b;
}
__device__ __forceinline__ void xcd_barrier_complete(unsigned* bar, unsigned x, unsigned& nloc, unsigned& nx) {
    const unsigned G = gridDim.x * gridDim.y * gridDim.z;
    unsigned sum, cnt, mine, sp = 0u;
    for (;;) {
        sum = 0u; cnt = 0u; mine = 0u;
#pragma unroll
        for (unsigned j = 0; j < 16; ++j) { const unsigned c = xb_ld(&bar[XB_XCNT(j)]); sum += c; cnt += (c > 0u) ? 1u : 0u; mine = (j == x) ? c : mine; }
        if (sum == G) break;
        __builtin_amdgcn_s_sleep(1);
        if ((++sp & 255u) == 0u) { if (xb_ld(&bar[XB_TMO])) break; if (sp > XB_SPIN_CAP) { atomicAdd(&bar[XB_TMO], 1u); break; } }
    }
    nloc = mine > 0u ? mine : 1u; nx = cnt > 0u ? cnt : 1u;
}
__device__ __forceinline__ void xcd_barrier(const XcdBarrier& b, const bool leader) {
    asm volatile("s_waitcnt vmcnt(0)" ::: "memory");
    __syncthreads();
    if (leader) {
        unsigned* bar = b.bar;
        __builtin_amdgcn_s_waitcnt(0);
        unsigned nloc = b.st[0], nx = b.st[1];
        if (nloc == 0u) { xcd_barrier_complete(bar, b.x, nloc, nx); b.st[0] = nloc; b.st[1] = nx; }
        const unsigned old = xb_add(&bar[XB_XSUB(b.x)], 1u);
        const unsigned gen = old / nloc;
        if (old + 1u == (gen + 1u) * nloc) {
            __builtin_amdgcn_fence(__ATOMIC_RELEASE, "agent");
            asm volatile("s_waitcnt vmcnt(0)" ::: "memory");
            const unsigned og = xb_add(&bar[XB_TOP], 1u);
            const unsigned tg = og / nx;
            if (og + 1u == (tg + 1u) * nx) xb_add(&bar[XB_TOPGEN], 1u);
            else XB_SPIN(xb_ld(&bar[XB_TOPGEN]) == tg, bar);
            __builtin_amdgcn_fence(__ATOMIC_ACQUIRE, "agent");
            xb_add(&bar[XB_XGEN(b.x)], 1u);
            asm volatile("s_waitcnt vmcnt(0)" ::: "memory");
        } else {
            XB_SPIN(xb_ld(&bar[XB_XGEN(b.x)]) == gen, bar);
            __builtin_amdgcn_fence(__ATOMIC_ACQUIRE, "agent");
            asm volatile("s_waitcnt vmcnt(0)" ::: "memory");
        }
    }
    __syncthreads();
}

enum { MK_ID = 0, MK_FFN1 = 1, MK_MIX = 2, MK_GATE = 3, MK_UQ = 4 };
__device__ __forceinline__ int srcmap(int kind, int v, float& sc) {
    sc = 1.f;
    if (kind == MK_ID) return v;
    if (kind == MK_FFN1) { const int pn = v >> 8, r = v & 255; return r < 128 ? 128 * pn + r : FF + 128 * pn + (r - 128); }
    if (kind == MK_GATE) { const int pn = v >> 8, r = v & 255, bj = r >> 7, wc = (r >> 5) & 3, n = (r >> 4) & 1, jj = r & 15; return 2980 + 1024 * (2 * bj + n) + 64 * pn + 16 * wc + jj; }
    if (kind == MK_UQ) { sc = 0.10206207261596577f * LOG2E; if (v < 256) return 96 * (v >> 6) + (v & 63); if (v < 384) { const int w = v - 256, rr = w & 31; return 96 * (w >> 5) + 64 + 16 * ((rr >> 2) & 1) + 4 * (rr >> 3) + (rr & 3); } return -1; }
    const int t = v >> 8, r = v & 255;
    switch (t) {
        case 0: sc = 0.125f * LOG2E; return r;
        case 1: return 256 + r;
        case 2: return 512 + r;
        case 3: return 772 + r;
        case 4: if (r < 128) return 1028 + r; if (r < 160) { const int rr = r - 128; return 1156 + 16 * ((rr >> 2) & 1) + 4 * (rr >> 3) + (rr & 3); } if (r < 164) return 768 + (r - 160); return -1;
        case 5: sc = 0.125f * LOG2E; return 1188 + r;
        case 6: return 1444 + r;
        case 7: return 1700 + r;
        case 8: return 1956 + r;
        case 9: return 2212 + r;
        case 10: return 2468 + r;
        default: return 2724 + r;
    }
}
__device__ __forceinline__ void conv_item(const float* __restrict__ W, int ldw, int Ksrc, int K, const float* __restrict__ gain, bf16_t* WT, int kind, LAS float* scr, int it, int nblk, int lane) {
    const int kb = it / nblk, nb = it % nblk, k0 = 64 * kb, n0 = 32 * nb;
    float sc; const int c = srcmap(kind, n0 + (lane & 31), sc);
    float gl = 1.f; if (gain && k0 + lane < Ksrc) gl = gain[k0 + lane];
    float v[32];
#pragma unroll
    for (int i = 0; i < 32; ++i) { const int k = k0 + 2 * i + (lane >> 5); v[i] = (c >= 0 && k < Ksrc) ? W[(size_t)k * ldw + c] : 0.f; }
#pragma unroll
    for (int i = 0; i < 32; ++i) { const int kk = 2 * i + (lane >> 5);
        const float g0 = __uint_as_float((unsigned)__builtin_amdgcn_readlane((int)__float_as_uint(gl), 2 * i)), g1 = __uint_as_float((unsigned)__builtin_amdgcn_readlane((int)__float_as_uint(gl), 2 * i + 1));
        scr[kk * 33 + (lane & 31)] = v[i] * sc * ((lane >> 5) ? g1 : g0); }
    LDS_WAIT(); asm volatile("" ::: "memory");
    const int ch = lane & 7;
#pragma unroll
    for (int j = 0; j < 4; ++j) { const int n = (lane >> 3) + 8 * j; const LAS float* s = scr + (8 * ch) * 33 + n;
        u32x4 o; o.x = cvt_pk_bf16(s[0 * 33], s[1 * 33]); o.y = cvt_pk_bf16(s[2 * 33], s[3 * 33]); o.z = cvt_pk_bf16(s[4 * 33], s[5 * 33]); o.w = cvt_pk_bf16(s[6 * 33], s[7 * 33]);
        *(u32x4*)(WT + (size_t)(n0 + n) * K + k0 + 8 * ch) = o; }
    LDS_WAIT(); asm volatile("" ::: "memory");
}
__device__ __forceinline__ void conv_item8(const float* __restrict__ W, int ldw, int K, const float* __restrict__ gain, unsigned char* WT8, int kind, LAS float* scr, int it, int nblk, int lane, float qs) {
    const int kb = it / nblk, nb = it % nblk, k0 = 64 * kb, n0 = 32 * nb;
    float sc; const int c = srcmap(kind, n0 + (lane & 31), sc); sc *= qs;
    float gl = 1.f; if (gain) gl = gain[k0 + lane];
    float v[32];
#pragma unroll
    for (int i = 0; i < 32; ++i) { const int k = k0 + 2 * i + (lane >> 5); v[i] = (c >= 0) ? W[(size_t)k * ldw + c] : 0.f; }
#pragma unroll
    for (int i = 0; i < 32; ++i) { const int kk = 2 * i + (lane >> 5);
        const float g0 = __uint_as_float((unsigned)__builtin_amdgcn_readlane((int)__float_as_uint(gl), 2 * i)), g1 = __uint_as_float((unsigned)__builtin_amdgcn_readlane((int)__float_as_uint(gl), 2 * i + 1));
        scr[kk * 33 + (lane & 31)] = v[i] * sc * ((lane >> 5) ? g1 : g0); }
    LDS_WAIT(); asm volatile("" ::: "memory");
    const int ch = lane & 3;
#pragma unroll
    for (int j = 0; j < 2; ++j) { const int n = (lane >> 2) + 16 * j; const LAS float* s = scr + (16 * ch) * 33 + n;
        u32x4 o; o.x = pk_fp8x4(s[0 * 33], s[1 * 33], s[2 * 33], s[3 * 33]); o.y = pk_fp8x4(s[4 * 33], s[5 * 33], s[6 * 33], s[7 * 33]);
        o.z = pk_fp8x4(s[8 * 33], s[9 * 33], s[10 * 33], s[11 * 33]); o.w = pk_fp8x4(s[12 * 33], s[13 * 33], s[14 * 33], s[15 * 33]);
        *(u32x4*)(WT8 + (size_t)(n0 + n) * K + k0 + 16 * ch) = o; }
    LDS_WAIT(); asm volatile("" ::: "memory");
}
struct ConvCtx { LAS float* scr; int gw, NGW, lane, base; };
__device__ __forceinline__ void conv_mat(ConvCtx& C, const float* W, int ldw, int Ksrc, int K, int Nv, const float* gain, bf16_t* WT, int kind) {
    const int nblk = Nv / 32, n = (K / 64) * nblk;
    int it = C.gw - (C.base % C.NGW); if (it < 0) it += C.NGW;
    for (; it < n; it += C.NGW) conv_item(W, ldw, Ksrc, K, gain, WT, kind, C.scr, it, nblk, C.lane);
    C.base += n;
}
__device__ __forceinline__ void conv_mat8(ConvCtx& C, const float* W, int ldw, int K, int Nv, const float* gain, unsigned char* WT8, int kind, float qs) {
    const int nblk = Nv / 32, n = (K / 64) * nblk;
    int it = C.gw - (C.base % C.NGW); if (it < 0) it += C.NGW;
    for (; it < n; it += C.NGW) conv_item8(W, ldw, K, gain, WT8, kind, C.scr, it, nblk, C.lane, qs);
    C.base += n;
}

namespace att {
constexpr int KSLOT = 12288, VSLOT = 8192;
constexpr int LDS_K = 0, LDS_V = 3 * KSLOT, LDS_WS = LDS_V + 2 * VSLOT, LDS_OST = LDS_WS + 8 * 256, LDS_FLAG = LDS_OST + 8 * 4096, LDS_TB = LDS_FLAG + 64, LDS_BYTES = LDS_TB + 1024;
static_assert(LDS_BYTES <= RING_BYTES, "attention scratch fits the ring region");
enum { FOX = 0, MLA = 1, SB = 2 };
struct Args { const bf16_t* Q; int ldq, hqs; const bf16_t* K; int ldk; const bf16_t* K2; const bf16_t* V; int ldv; const float* TB; const float* KMX; bf16_t* O; };
__device__ __forceinline__ int crow(int r, int hi) { return (r & 3) + 8 * (r >> 2) + 4 * hi; }
__device__ __forceinline__ void glds16(const void* gsrc, unsigned lds_dst) { unsigned keep;
    asm volatile("s_mov_b32 %0, m0\n\ts_mov_b32 m0, %2\n\ts_nop 0\n\tglobal_load_lds_dwordx4 %1, off\n\ts_mov_b32 m0, %0" : "=&s"(keep) : "v"(gsrc), "s"(lds_dst) : "memory"); }
#define ATT_MFMA(a, b, c) __builtin_amdgcn_mfma_f32_32x32x16_bf16(a, b, c, 0, 0, 0)
__device__ __forceinline__ void pv(f32x16* o, int vb, bf16x8 pa0, bf16x8 pa1, bf16x8 pa2, bf16x8 pa3) {
    s16x4 lo[2][4], hi[2][4];
#pragma unroll
    for (int d0 = 0; d0 < 2; ++d0)
#pragma unroll
        for (int ks = 0; ks < 4; ++ks) {
            asm volatile("ds_read_b64_tr_b16 %0,%1 offset:%c2" : "=&v"(lo[d0][ks]) : "v"(vb), "i"(d0 * 4096 + ks * 1024) : "memory");
            asm volatile("ds_read_b64_tr_b16 %0,%1 offset:%c2" : "=&v"(hi[d0][ks]) : "v"(vb), "i"(d0 * 4096 + ks * 1024 + 512) : "memory"); }
#define ATT_PK(d, k) (bf16x8){lo[d][k][0], lo[d][k][1], lo[d][k][2], lo[d][k][3], hi[d][k][0], hi[d][k][1], hi[d][k][2], hi[d][k][3]}
    asm volatile("s_waitcnt lgkmcnt(8)" : "+v"(lo[0][0]), "+v"(lo[0][1]), "+v"(lo[0][2]), "+v"(lo[0][3]), "+v"(hi[0][0]), "+v"(hi[0][1]), "+v"(hi[0][2]), "+v"(hi[0][3]) :: "memory"); __builtin_amdgcn_sched_barrier(0);
    o[0] = ATT_MFMA(pa0, ATT_PK(0, 0), o[0]); o[0] = ATT_MFMA(pa1, ATT_PK(0, 1), o[0]); o[0] = ATT_MFMA(pa2, ATT_PK(0, 2), o[0]); o[0] = ATT_MFMA(pa3, ATT_PK(0, 3), o[0]);
    asm volatile("s_waitcnt lgkmcnt(0)" : "+v"(lo[1][0]), "+v"(lo[1][1]), "+v"(lo[1][2]), "+v"(lo[1][3]), "+v"(hi[1][0]), "+v"(hi[1][1]), "+v"(hi[1][2]), "+v"(hi[1][3]) :: "memory"); __builtin_amdgcn_sched_barrier(0);
    o[1] = ATT_MFMA(pa0, ATT_PK(1, 0), o[1]); o[1] = ATT_MFMA(pa1, ATT_PK(1, 1), o[1]); o[1] = ATT_MFMA(pa2, ATT_PK(1, 2), o[1]); o[1] = ATT_MFMA(pa3, ATT_PK(1, 3), o[1]);
#undef ATT_PK
}
template <int MODE, bool EARLY>
__device__ __forceinline__ void attn_unit_impl(char* shm, int b, int h, int qb, const Args& A, const int wv) {
    constexpr int NQ = (MODE == MLA) ? 6 : 4;
    constexpr int LDQ = (MODE == MLA) ? 384 : NMIX, HQS = (MODE == MLA) ? 96 : 64, LDK = (MODE == MLA) ? 256 : NMIX, LDV = LDK;
    constexpr bool LS = (MODE != SB);
    constexpr float THR = 8.f;
    int tid_ = (wv << 6) | lane_id(); asm volatile("" : "+v"(tid_));
    const int tid = tid_, lane = tid & 63, r32 = lane & 31, hi = lane >> 5; const int wid = wv;
    const long rowbase = (long)b * SEQ; const int q0 = qb * 256; const int bh = b * 4 + h;
    const unsigned lds0 = (unsigned)(uintptr_t)shm;
    float* wsf = (float*)(shm + LDS_WS) + wid * 64;
    const bf16_t* Qw = A.Q + (rowbase + q0 + wid * 32) * LDQ + h * HQS;
    const bf16_t* Kh = A.K + rowbase * LDK + h * 64; const bf16_t* Vh = A.V + rowbase * LDV + h * 64;
    const bf16_t* ksrc = Kh + (long)lane * LDK + wid * 8;
    const bf16_t* ksrc2 = (MODE == MLA) ? A.K2 + (rowbase + lane) * 32 + (wid & 3) * 8 : (MODE == FOX) ? A.K2 + ((long)bh * SEQ + lane) * 8 : nullptr;
    const bf16_t* vsrc = Vh + (long)(16 * (wid & 3) + (lane >> 2)) * LDV + (wid >> 2) * 32 + (lane & 3) * 8;
    const float* TBh = (MODE == FOX) ? A.TB + bh * 128 : nullptr; const float* KMh = (MODE == FOX) ? A.KMX + bh * 128 : nullptr;
    const int NT = (q0 + 256) / 64;
#define ATT_DMA_K(t, s) do { const long kt_ = (long)(t) * 64; \
        glds16(ksrc + kt_ * LDK, (unsigned)__builtin_amdgcn_readfirstlane(lds0 + LDS_K + (s) * KSLOT + wid * 1024)); \
        if (MODE == MLA) { if (wid < 4) glds16(ksrc2 + kt_ * 32, (unsigned)__builtin_amdgcn_readfirstlane(lds0 + LDS_K + (s) * KSLOT + (8 + wid) * 1024)); } \
        if (MODE == FOX) { if (wid == 7) glds16(ksrc2 + kt_ * 8, (unsigned)__builtin_amdgcn_readfirstlane(lds0 + LDS_K + (s) * KSLOT + 8 * 1024)); } } while (0)
#define ATT_DMA_V(t, s) glds16(vsrc + (long)(t) * 64 * LDV, (unsigned)__builtin_amdgcn_readfirstlane(lds0 + LDS_V + (s) * VSLOT + wid * 1024))
    ATT_DMA_K(NT - 1, 0); ATT_DMA_V(NT - 1, 0); if (NT > 1) ATT_DMA_K(NT - 2, 1);
    bf16x8 qr[NQ];
#pragma unroll
    for (int d0 = 0; d0 < NQ; ++d0) qr[d0] = *reinterpret_cast<const bf16x8*>(&Qw[(long)r32 * LDQ + d0 * 16 + hi * 8]);
    const bf16x8 qone = (hi == 0) ? (bf16x8){(short)0x3F80, (short)0x3F80, 0, 0, 0, 0, 0, 0} : (bf16x8){0, 0, 0, 0, 0, 0, 0, 0};
    const bf16x8 ones = {(short)0x3F80, (short)0x3F80, (short)0x3F80, (short)0x3F80, (short)0x3F80, (short)0x3F80, (short)0x3F80, (short)0x3F80};
    const int qg = q0 + wid * 32 + r32;
    float qn = 0.f;
    if (MODE == FOX) {
#pragma unroll
        for (int d0 = 0; d0 < 4; ++d0)
#pragma unroll
            for (int j = 0; j < 8; ++j) { const float v = __uint_as_float(((unsigned)(unsigned short)qr[d0][j]) << 16); qn += v * v; }
        qn = x32_sum(qn); qn = sqrtf(qn) * 1.0001f; }
    f32x16 o[2]; o[0] = f32x16{}; o[1] = f32x16{};
    f32x16 lacc = f32x16{};
    f32x16 ng = f32x16{};
    float lrun = 0.f; float mrun = -INFINITY, Rrun = 0.f;
    float mused = 0.f, mused_n = 0.f;
    const int vb0 = (int)(lds0 + LDS_V) + ((lane >> 4) & 1) * 32 + (lane & 3) * 8 + (4 * hi + ((lane & 15) >> 2)) * 64;
    volatile int* flags = (volatile int*)(shm + LDS_FLAG);
    if (MODE != MLA) { if (tid < 16) flags[tid] = 0; }
    float* tbs = (float*)(shm + LDS_TB);
    if (MODE == FOX) { if (tid < 128) tbs[tid] = TBh[tid]; else if (tid < 256) tbs[tid] = KMh[tid - 128]; }
    f32x16 p0, p1, n0, n1;
#define ATT_KRD(dst, areg, off) asm volatile("ds_read_b128 %0, %1 offset:%c2" : "=&v"(dst) : "v"(areg), "i"(off) : "memory")
#define ATT_QK(D0, D1, ks, CT) do { const unsigned ka_ = lds0 + LDS_K + (ks) * KSLOT + hi * 1024 + r32 * 16; bf16x8 kf_[2 * NQ]; bf16x8 kx0_, kx1_; \
        _Pragma("unroll") for (int d0 = 0; d0 < NQ; ++d0) { ATT_KRD(kf_[2 * d0], ka_, d0 * 2048); ATT_KRD(kf_[2 * d0 + 1], ka_, d0 * 2048 + 512); } \
        if (MODE == FOX) { const unsigned kb_ = lds0 + LDS_K + (ks) * KSLOT + 8 * 1024 + r32 * 16; ATT_KRD(kx0_, kb_, 0); ATT_KRD(kx1_, kb_, 512); } \
        if (MODE == MLA) asm volatile("s_waitcnt lgkmcnt(6)" : "+v"(kf_[0]), "+v"(kf_[1]), "+v"(kf_[2]), "+v"(kf_[3]), "+v"(kf_[4]), "+v"(kf_[5]) :: "memory"); \
        else if (MODE == FOX) asm volatile("s_waitcnt lgkmcnt(6)" : "+v"(kf_[0]), "+v"(kf_[1]), "+v"(kf_[2]), "+v"(kf_[3]) :: "memory"); \
        else asm volatile("s_waitcnt lgkmcnt(4)" : "+v"(kf_[0]), "+v"(kf_[1]), "+v"(kf_[2]), "+v"(kf_[3]) :: "memory"); \
        __builtin_amdgcn_sched_barrier(0); \
        D0 = ATT_MFMA(kf_[0], qr[0], CT); D1 = ATT_MFMA(kf_[1], qr[0], CT); D0 = ATT_MFMA(kf_[2], qr[1], D0); D1 = ATT_MFMA(kf_[3], qr[1], D1); \
        if (MODE == MLA) { D0 = ATT_MFMA(kf_[4], qr[2], D0); D1 = ATT_MFMA(kf_[5], qr[2], D1); \
            asm volatile("s_waitcnt lgkmcnt(0)" : "+v"(kf_[6]), "+v"(kf_[7]), "+v"(kf_[8]), "+v"(kf_[9]), "+v"(kf_[10]), "+v"(kf_[11]) :: "memory"); __builtin_amdgcn_sched_barrier(0); \
            _Pragma("unroll") for (int d0 = 3; d0 < NQ; ++d0) { D0 = ATT_MFMA(kf_[2 * d0], qr[d0], D0); D1 = ATT_MFMA(kf_[2 * d0 + 1], qr[d0], D1); } } \
        else if (MODE == FOX) { asm volatile("s_waitcnt lgkmcnt(0)" : "+v"(kf_[4]), "+v"(kf_[5]), "+v"(kf_[6]), "+v"(kf_[7]), "+v"(kx0_), "+v"(kx1_) :: "memory"); __builtin_amdgcn_sched_barrier(0); \
            D0 = ATT_MFMA(kf_[4], qr[2], D0); D1 = ATT_MFMA(kf_[5], qr[2], D1); D0 = ATT_MFMA(kf_[6], qr[3], D0); D1 = ATT_MFMA(kf_[7], qr[3], D1); D0 = ATT_MFMA(kx0_, qone, D0); D1 = ATT_MFMA(kx1_, qone, D1); } \
        else { asm volatile("s_waitcnt lgkmcnt(0)" : "+v"(kf_[4]), "+v"(kf_[5]), "+v"(kf_[6]), "+v"(kf_[7]) :: "memory"); __builtin_amdgcn_sched_barrier(0); \
            D0 = ATT_MFMA(kf_[4], qr[2], D0); D1 = ATT_MFMA(kf_[5], qr[2], D1); D0 = ATT_MFMA(kf_[6], qr[3], D0); D1 = ATT_MFMA(kf_[7], qr[3], D1); } } while (0)
#define ATT_NEXT(tn, fast) do { float tbn_ = 0.f; if (MODE == FOX) tbn_ = tbs[(tn)]; \
        if ((fast) && MODE == FOX) { const float c_ = tbn_ - mrun; _Pragma("unroll") for (int r = 0; r < 16; ++r) ng[r] = c_; asm volatile("" : "+v"(ng)); mused_n = mrun; } else mused_n = tbn_; \
        ATT_QK(n0, n1, ksn, ng); } while (0)
#define MX3(a, b, c) __builtin_fmaxf(__builtin_fmaxf((a), (b)), (c))
    asm volatile("s_waitcnt vmcnt(0) lgkmcnt(0)\n\ts_barrier" ::: "memory");
    ATT_QK(p0, p1, 0, ng); if (MODE == FOX) mused = tbs[NT - 1];
    int ksn = 1, ksp = 2;
    auto tile = [&](f32x16& p0, f32x16& p1, float& mused, f32x16& n0, f32x16& n1, float& mused_n, const int it) __attribute__((always_inline)) -> bool {
        const int t = NT - 1 - it, vs = it & 1;
        if (it > 0) {
            asm volatile("s_waitcnt vmcnt(0) lgkmcnt(0)\n\ts_barrier" ::: "memory");
            if (MODE != MLA) { int alld = 1;
#pragma unroll
                for (int w = 0; w < 8; ++w) alld &= flags[((it - 1) & 1) * 8 + w];
                if (alld) return true; }
        }
        if (it + 2 < NT) ATT_DMA_K(t - 2, ksp);
        if (it + 1 < NT) ATT_DMA_V(t - 1, vs ^ 1);
        const bool fastn = (it >= 3);
        if (EARLY) { if (it + 1 < NT) ATT_NEXT(t - 1, fastn && it >= 4); }
        {
            const int kbase = 64 * t + 4 * hi;
            if (MODE != SB) {
                float tbt = 0.f; if (MODE == FOX) tbt = tbs[t];
                if (it < 4) {
#pragma unroll
                    for (int r = 0; r < 16; ++r) { const int kv = kbase + (r & 3) + 8 * (r >> 2); if (kv > qg) p0[r] = -INFINITY; if (kv + 32 > qg) p1[r] = -INFINITY; }
                    float rm = fmaxf(p0[0], p1[0]);
#pragma unroll
                    for (int r = 1; r < 16; ++r) rm = fmaxf(rm, fmaxf(p0[r], p1[r]));
                    rm = x32_max(rm);
                    const float rma = rm + mused;
                    if (__any(rma > mrun)) {
                        const float mnew = fmaxf(mrun, rma), alpha = (mrun == -INFINITY) ? 1.f : fast_exp2(mrun - mnew); mrun = mnew; lrun *= alpha;
                        if (hi == 0) wsf[r32] = alpha;
                        LDS_WAIT();
#pragma unroll
                        for (int g = 0; g < 4; ++g) { const f32x4 a4 = *(const f32x4*)(wsf + 8 * g + 4 * hi);
#pragma unroll
                            for (int i = 0; i < 4; ++i) { o[0][4 * g + i] *= a4[i]; o[1][4 * g + i] *= a4[i]; if (LS) lacc[4 * g + i] *= a4[i]; } }
                    }
                    const float mrel = ((mrun == -INFINITY) ? 0.f : mrun) - mused;
#pragma unroll
                    for (int r = 0; r < 16; ++r) { p0[r] = fast_exp2(p0[r] - mrel); p1[r] = fast_exp2(p1[r] - mrel); }
                    if (!LS) { float sa = 0.f;
#pragma unroll
                        for (int r = 0; r < 16; ++r) sa += p0[r] + p1[r];
                        lrun += sa; }
                } else {
                    const float dl = mrun - mused;
                    float ra = MX3(p0[0], p0[1], p1[0]), rb = MX3(p0[2], p0[3], p1[1]); ra = MX3(ra, p1[2], p1[3]);
#pragma unroll
                    for (int r = 4; r < 16; r += 4) { ra = MX3(ra, p0[r], p0[r + 1]); rb = MX3(rb, p0[r + 2], p0[r + 3]); ra = MX3(ra, p1[r], p1[r + 1]); rb = MX3(rb, p1[r + 2], p1[r + 3]); }
                    const float rm = x32_max(fmaxf(ra, rb)) - dl;
                    if (__any(rm > THR)) {
                        const float d = fmaxf(rm, 0.f), alpha = fast_exp2(-d); mrun += d;
                        if (hi == 0) wsf[r32] = alpha;
                        LDS_WAIT();
#pragma unroll
                        for (int g = 0; g < 4; ++g) { const f32x4 a4 = *(const f32x4*)(wsf + 8 * g + 4 * hi);
#pragma unroll
                            for (int i = 0; i < 4; ++i) { o[0][4 * g + i] *= a4[i]; o[1][4 * g + i] *= a4[i]; lacc[4 * g + i] *= a4[i]; } }
                    }
                    const float sub = mrun - mused;
                    if (MODE == MLA || __any(sub != 0.f)) {
#pragma unroll
                        for (int r = 0; r < 16; ++r) { p0[r] = fast_exp2(p0[r] - sub); p1[r] = fast_exp2(p1[r] - sub); }
                    } else {
#pragma unroll
                        for (int r = 0; r < 16; ++r) { p0[r] = fast_exp2(p0[r]); p1[r] = fast_exp2(p1[r]); }
                    }
                }
                if (MODE == FOX) {
                    int done = 0; if (t > 0) done = __all(qn * tbs[128 + t - 1] + tbs[t - 1] - mrun < -150.f) ? 1 : 0;
                    if (lane == 0) flags[(it & 1) * 8 + wid] = done; }
                (void)tbt;
            } else {
                f32x16 l0, l1;
#pragma unroll
                for (int r = 0; r < 16; ++r) { const int kv = kbase + (r & 3) + 8 * (r >> 2);
                    { const float z = p0[r], sp = fmaxf(z, 0.f) + fast_log2(1.f + fast_exp2(-fabsf(z))); const bool ok = kv < qg; l0[r] = ok ? -sp : 0.f; p0[r] = ok ? z - sp : -INFINITY; }
                    { const float z = p1[r], sp = fmaxf(z, 0.f) + fast_log2(1.f + fast_exp2(-fabsf(z))); const bool ok = kv + 32 < qg; l1[r] = ok ? -sp : 0.f; p1[r] = ok ? z - sp : -INFINITY; } }
                float gs[8], og[8];
#pragma unroll
                for (int g = 0; g < 4; ++g) { gs[g] = (l0[4 * g] + l0[4 * g + 1]) + (l0[4 * g + 2] + l0[4 * g + 3]); gs[4 + g] = (l1[4 * g] + l1[4 * g + 1]) + (l1[4 * g + 2] + l1[4 * g + 3]); }
#pragma unroll
                for (int g = 0; g < 8; ++g) og[g] = x32_other(gs[g], hi);
                float run = Rrun;
#pragma unroll
                for (int g = 7; g >= 0; --g) {
                    const float aft = run + (hi == 0 ? og[g] : 0.f);
                    if (g >= 4) { const int r = 4 * (g - 4); float c = aft; p1[r + 3] = fast_exp2(p1[r + 3] + c); c += l1[r + 3]; p1[r + 2] = fast_exp2(p1[r + 2] + c); c += l1[r + 2]; p1[r + 1] = fast_exp2(p1[r + 1] + c); c += l1[r + 1]; p1[r] = fast_exp2(p1[r] + c); }
                    else        { const int r = 4 * g;       float c = aft; p0[r + 3] = fast_exp2(p0[r + 3] + c); c += l0[r + 3]; p0[r + 2] = fast_exp2(p0[r + 2] + c); c += l0[r + 2]; p0[r + 1] = fast_exp2(p0[r + 1] + c); c += l0[r + 1]; p0[r] = fast_exp2(p0[r] + c); }
                    run += gs[g] + og[g];
                }
                Rrun = run;
                const int done = __all(Rrun < -160.f) ? 1 : 0;
                if (lane == 0) flags[(it & 1) * 8 + wid] = done;
            }
            const bf16x8 pa0 = __builtin_bit_cast(bf16x8, (u32x4){cvt_pk_bf16(p0[0], p0[1]), cvt_pk_bf16(p0[2], p0[3]), cvt_pk_bf16(p0[4], p0[5]), cvt_pk_bf16(p0[6], p0[7])});
            const bf16x8 pa1 = __builtin_bit_cast(bf16x8, (u32x4){cvt_pk_bf16(p0[8], p0[9]), cvt_pk_bf16(p0[10], p0[11]), cvt_pk_bf16(p0[12], p0[13]), cvt_pk_bf16(p0[14], p0[15])});
            const bf16x8 pa2 = __builtin_bit_cast(bf16x8, (u32x4){cvt_pk_bf16(p1[0], p1[1]), cvt_pk_bf16(p1[2], p1[3]), cvt_pk_bf16(p1[4], p1[5]), cvt_pk_bf16(p1[6], p1[7])});
            const bf16x8 pa3 = __builtin_bit_cast(bf16x8, (u32x4){cvt_pk_bf16(p1[8], p1[9]), cvt_pk_bf16(p1[10], p1[11]), cvt_pk_bf16(p1[12], p1[13]), cvt_pk_bf16(p1[14], p1[15])});
            pv(o, vb0 + vs * VSLOT, pa0, pa1, pa2, pa3);
            if (LS) { lacc = ATT_MFMA(pa0, ones, lacc); lacc = ATT_MFMA(pa1, ones, lacc); lacc = ATT_MFMA(pa2, ones, lacc); lacc = ATT_MFMA(pa3, ones, lacc); }
        }
        if (!EARLY) { if (it + 1 < NT) ATT_NEXT(t - 1, fastn); }
        ksn = ksp; ksp = (ksp == 2) ? 0 : ksp + 1;
        return false;
    };
    for (int it = 0; it < NT; it += 2) {
        if (tile(p0, p1, mused, n0, n1, mused_n, it)) break;
        if (tile(n0, n1, mused_n, p0, p1, mused, it + 1)) break;
    }
    bf16_t* Ow = A.O + (rowbase + q0 + wid * 32) * DM + h * 64;
    { __hip_bfloat16* stg = (__hip_bfloat16*)(shm + LDS_OST) + wid * 2048;
#pragma unroll
        for (int r = 0; r < 16; ++r) { const int orow = crow(r, hi); const float rl = LS ? fast_rcp(lacc[r]) : 1.f;
#pragma unroll
            for (int d0 = 0; d0 < 2; ++d0) stg[orow * 64 + d0 * 32 + r32] = __float2bfloat16(o[d0][r] * rl); }
        LDS_WAIT();
#pragma unroll
        for (int i = 0; i < 4; ++i) { const int row = i * 8 + (lane >> 3), ch = lane & 7; const u32x4 v = *(const u32x4*)(stg + row * 64 + ch * 8); *(u32x4*)(Ow + (long)row * DM + ch * 8) = v; } }
    asm volatile("s_waitcnt vmcnt(0) lgkmcnt(0)\n\ts_barrier" ::: "memory");
#undef ATT_DMA_K
#undef ATT_DMA_V
#undef ATT_QK
#undef ATT_KRD
#undef ATT_NEXT
#undef MX3
}
template <int MODE>
__device__ __forceinline__ void attn_unit(char* shm, int b, int h, int qb, const Args& A, const int wv) {
    if (wv < 4) attn_unit_impl<MODE, true>(shm, b, h, qb, A, wv); else attn_unit_impl<MODE, false>(shm, b, h, qb, A, wv);
}
#undef ATT_MFMA
}

namespace hg {
constexpr int PF = 68;
constexpr int PD = 72, PS_ = 40;
constexpr int B_QX = 0, B_KDT = B_QX + 32 * PD * 2, B_VT = B_KDT + 64 * PS_ * 2, B_ST = B_VT + 64 * PS_ * 2, B_SC = B_ST + 64 * PD * 2, B_Q1 = B_SC + 32 * PS_ * 2, B_K0 = B_Q1 + 16 * PD * 2,
    B_QR = B_K0 + 16 * PD * 2, B_KR = B_QR + 32 * PF * 4, B_BC = B_KR + 32 * PF * 4, B_G = B_BC + 32 * PF * 4, B_BL = B_G + 32 * PF * 4, B_PS = B_BL + 256, B_END = B_PS + 512;
static_assert(B_END <= RING_BYTES && (B_QR % 16) == 0 && (B_KDT % 16) == 0 && (B_SC % 16) == 0, "HGRN scratch");
struct Args { const bf16_t* MIX; const float* lb_logits; const float* out_norm; float* SLOC; float* LSEG; bf16_t* YS; int layer; };
struct Raw { u32x2 q, f, i, g; };
#define HG_MFMA(a, b, c) __builtin_amdgcn_mfma_f32_16x16x32_bf16(a, b, c, 0, 0, 0)
#define HG_SYNC() asm volatile("s_waitcnt lgkmcnt(0)\n\ts_barrier" ::: "memory")
template <bool STAGE2>
__device__ __forceinline__ void load_raw(Raw& R, const Args& A, long row0, int h, int wid, int lane) {
    const bf16_t* src = A.MIX + (row0 + (lane & 31)) * NMIX + 64 * h + 8 * wid + 4 * (lane >> 5);
    R.f = *(const u32x2*)(src + MX_HF); R.i = *(const u32x2*)(src + MX_HI);
    if (STAGE2) { R.q = *(const u32x2*)(src + MX_HQ); R.g = *(const u32x2*)(src + MX_HG); }
}
__device__ __forceinline__ void st_bf16(LAS unsigned char* L, int byteoff, float v) { *(LAS bf16_t*)(L + byteoff) = (bf16_t)(cvt_pk_bf16(v, 0.f) & 0xffffu); }
template <bool STAGE2>
__device__ __forceinline__ void transform(LAS unsigned char* L, const Raw& R, const float (&lbv)[4], float (&seglog)[4], int wid, int lane) {
    const int t = lane & 31, d0 = 8 * wid + 4 * (lane >> 5);
    const float hf[4] = {bf_lo(R.f.x), bf_hi(R.f.x), bf_lo(R.f.y), bf_hi(R.f.y)}, v[4] = {bf_lo(R.i.x), bf_hi(R.i.x), bf_lo(R.i.y), bf_hi(R.i.y)};
    float k[4], bc[4];
#pragma unroll
    for (int i = 0; i < 4; ++i) { const float f = lbv[i] + (1.f - lbv[i]) * sigmoidf_(hf[i]); k[i] = 1.f - f; bc[i] = fast_log2(f); }
#pragma unroll
    for (int off = 1; off < 32; off <<= 1) {
#pragma unroll
        for (int i = 0; i < 4; ++i) { const float y = bperm(bc[i], lane - off); if (t >= off) bc[i] += y; } }
    float bl[4], b15[4];
#pragma unroll
    for (int i = 0; i < 4; ++i) { bl[i] = bperm(bc[i], lane | 31); b15[i] = bperm(bc[i], (lane & 32) | 15); }
#pragma unroll
    for (int i = 0; i < 4; ++i) { st_bf16(L, B_KDT + ((d0 + i) * PS_ + t) * 2, k[i] * fast_exp2(bl[i] - bc[i])); st_bf16(L, B_VT + ((d0 + i) * PS_ + t) * 2, v[i]); }
    if (t == 31) { *(LAS f32x4*)(L + B_BL + d0 * 4) = (f32x4){fast_exp2(bl[0]), fast_exp2(bl[1]), fast_exp2(bl[2]), fast_exp2(bl[3])};
#pragma unroll
        for (int i = 0; i < 4; ++i) seglog[i] += bl[i]; }
    if (STAGE2) {
        const float q[4] = {bf_lo(R.q.x), bf_hi(R.q.x), bf_lo(R.q.y), bf_hi(R.q.y)}, g[4] = {bf_lo(R.g.x), bf_hi(R.g.x), bf_lo(R.g.y), bf_hi(R.g.y)};
        { u32x2 w; w.x = cvt_pk_bf16(q[0] * fast_exp2(bc[0]), q[1] * fast_exp2(bc[1])); w.y = cvt_pk_bf16(q[2] * fast_exp2(bc[2]), q[3] * fast_exp2(bc[3])); *(LAS u32x2*)(L + B_QX + (t * PD + d0) * 2) = w; }
        if (t >= 16) { u32x2 w; w.x = cvt_pk_bf16(q[0] * fast_exp2(bc[0] - b15[0]), q[1] * fast_exp2(bc[1] - b15[1])); w.y = cvt_pk_bf16(q[2] * fast_exp2(bc[2] - b15[2]), q[3] * fast_exp2(bc[3] - b15[3])); *(LAS u32x2*)(L + B_Q1 + ((t - 16) * PD + d0) * 2) = w; }
        else         { u32x2 w; w.x = cvt_pk_bf16(k[0] * fast_exp2(b15[0] - bc[0]), k[1] * fast_exp2(b15[1] - bc[1])); w.y = cvt_pk_bf16(k[2] * fast_exp2(b15[2] - bc[2]), k[3] * fast_exp2(b15[3] - bc[3])); *(LAS u32x2*)(L + B_K0 + (t * PD + d0) * 2) = w; }
        *(LAS f32x4*)(L + B_QR + (t * PF + d0) * 4) = (f32x4){q[0], q[1], q[2], q[3]}; *(LAS f32x4*)(L + B_KR + (t * PF + d0) * 4) = (f32x4){k[0], k[1], k[2], k[3]};
        *(LAS f32x4*)(L + B_BC + (t * PF + d0) * 4) = (f32x4){bc[0], bc[1], bc[2], bc[3]};
        *(LAS f32x4*)(L + B_G + (t * PF + d0) * 4) = (f32x4){g[0] * sigmoidf_(g[0]), g[1] * sigmoidf_(g[1]), g[2] * sigmoidf_(g[2]), g[3] * sigmoidf_(g[3])};
    }
}
__device__ __forceinline__ void state_update(LAS unsigned char* L, f32x4 (&S)[2], int wid, int lane, bool mma) {
    const int dm = wid >> 1, lr = lane & 15, lq = lane >> 4;
    if (mma) {
        const f32x4 e = *(LAS f32x4*)(L + B_BL + (16 * dm + 4 * lq) * 4);
        const bf16x8 a = *(LAS bf16x8*)(L + B_KDT + ((16 * dm + lr) * PS_ + 8 * lq) * 2);
#pragma unroll
        for (int x = 0; x < 2; ++x) { const int vn = 2 * (wid & 1) + x; const bf16x8 b = *(LAS bf16x8*)(L + B_VT + ((16 * vn + lr) * PS_ + 8 * lq) * 2);
            S[x] = S[x] * e; S[x] = HG_MFMA(a, b, S[x]); }
    }
#pragma unroll
    for (int x = 0; x < 2; ++x) { const int vn = 2 * (wid & 1) + x; u32x2 w; w.x = cvt_pk_bf16(S[x][0], S[x][1]); w.y = cvt_pk_bf16(S[x][2], S[x][3]);
        *(LAS u32x2*)(L + B_ST + ((16 * vn + lr) * PD + 16 * dm + 4 * lq) * 2) = w; }
}
__device__ __forceinline__ void lower_bounds(const Args& A, int h, int d0, float (&lbv)[4]) {
#pragma unroll
    for (int i = 0; i < 4; ++i) { const int c = 64 * h + d0 + i; float lg[4], mx = -INFINITY;
#pragma unroll
        for (int l = 0; l < 4; ++l) { lg[l] = A.lb_logits[l * 256 + c]; mx = fmaxf(mx, lg[l]); }
        float den = 0.f, num = 0.f;
#pragma unroll
        for (int l = 0; l < 4; ++l) { const float e = __expf(lg[l] - mx); den += e; if (l >= 1 && l <= A.layer) num += e; }
        lbv[i] = num / den; }
}
__device__ __forceinline__ void stage1_unit(LAS unsigned char* L, const Args& A, int bh, int seg, const int wv) {
    int tid_ = (wv << 6) | lane_id(); asm volatile("" : "+v"(tid_));
    const int tid = tid_, lane = tid & 63, wid = wv;
    const int h = bh & 3; const long row0 = (long)(bh >> 2) * SEQ + seg * 256; const int d0 = 8 * wid + 4 * (lane >> 5);
    float lbv[4]; lower_bounds(A, h, d0, lbv);
    float seglog[4] = {0.f, 0.f, 0.f, 0.f};
    f32x4 S[2]; S[0] = (f32x4){0.f, 0.f, 0.f, 0.f}; S[1] = S[0];
    Raw R; load_raw<false>(R, A, row0, h, wid, lane);
    for (int c = 0; c < 8; ++c) {
        transform<false>(L, R, lbv, seglog, wid, lane);
        if (c + 1 < 8) load_raw<false>(R, A, row0 + 32 * (c + 1), h, wid, lane);
        HG_SYNC();
        state_update(L, S, wid, lane, true);
        HG_SYNC();
    }
    const int u = bh * 32 + seg, dm = wid >> 1, lr = lane & 15, lq = lane >> 4;
#pragma unroll
    for (int x = 0; x < 2; ++x) { const int vn = 2 * (wid & 1) + x;
#pragma unroll
        for (int i = 0; i < 4; ++i) A.SLOC[((size_t)u * 64 + 16 * dm + 4 * lq + i) * 64 + 16 * vn + lr] = S[x][i]; }
    if ((lane & 31) == 31) { *(f32x4*)(A.LSEG + (size_t)u * 64 + d0) = (f32x4){seglog[0], seglog[1], seglog[2], seglog[3]}; }
}
__device__ __forceinline__ void stage2_unit(LAS unsigned char* L, const Args& A, int bh, int seg, const int wv) {
    int tid_ = (wv << 6) | lane_id(); asm volatile("" : "+v"(tid_));
    const int tid = tid_, lane = tid & 63, wid = wv;
    const int h = bh & 3; const long row0 = (long)(bh >> 2) * SEQ + seg * 256; const int d0 = 8 * wid + 4 * (lane >> 5);
    const int lr = lane & 15, lq = lane >> 4;
    float lbv[4]; lower_bounds(A, h, d0, lbv);
    float seglog[4] = {0.f, 0.f, 0.f, 0.f};
    f32x4 S[2]; S[0] = (f32x4){0.f, 0.f, 0.f, 0.f}; S[1] = S[0];
    Raw R; load_raw<true>(R, A, row0, h, wid, lane);
    {
        const int dm = wid >> 1;
        int j = 0;
        for (; j + 4 <= seg; j += 4) {
            f32x4 lg[4]; float loc[4][2][4];
#pragma unroll
            for (int q = 0; q < 4; ++q) { const int u = bh * 32 + j + q; lg[q] = *(const f32x4*)(A.LSEG + (size_t)u * 64 + 16 * dm + 4 * lq);
#pragma unroll
                for (int x = 0; x < 2; ++x) { const int vn = 2 * (wid & 1) + x;
#pragma unroll
                    for (int i = 0; i < 4; ++i) loc[q][x][i] = A.SLOC[((size_t)u * 64 + 16 * dm + 4 * lq + i) * 64 + 16 * vn + lr]; } }
#pragma unroll
            for (int q = 0; q < 4; ++q)
#pragma unroll
                for (int x = 0; x < 2; ++x)
#pragma unroll
                    for (int i = 0; i < 4; ++i) S[x][i] = S[x][i] * fast_exp2(lg[q][i]) + loc[q][x][i];
        }
        for (; j < seg; ++j) { const int u = bh * 32 + j; const f32x4 lg = *(const f32x4*)(A.LSEG + (size_t)u * 64 + 16 * dm + 4 * lq);
#pragma unroll
            for (int x = 0; x < 2; ++x) { const int vn = 2 * (wid & 1) + x;
#pragma unroll
                for (int i = 0; i < 4; ++i) S[x][i] = S[x][i] * fast_exp2(lg[i]) + A.SLOC[((size_t)u * 64 + 16 * dm + 4 * lq + i) * 64 + 16 * vn + lr]; } }
        state_update(L, S, wid, lane, false);
        for (int i = tid; i < 32 * PS_ / 2; i += 512) *(LAS unsigned*)(L + B_SC + i * 4) = 0u;
    }
    const f32x4 gn4 = {A.out_norm[64 * h + 16 * (wid & 3) + lr], 0.f, 0.f, 0.f};
    for (int c = 0; c < 8; ++c) {
        const long crow0 = row0 + 32 * c;
        transform<true>(L, R, lbv, seglog, wid, lane);
        if (c + 1 < 8) load_raw<true>(R, A, crow0 + 32, h, wid, lane);
        HG_SYNC();
        {
            float sc = 0.f; int tt = 0, ss = 0;
            if (tid < 480) {
                const int blk = tid >= 240 ? 1 : 0, r = tid - 240 * blk, j = r >> 1, dh = r & 1; int tl, sl;
                if (j < 112) { const int rp = j >> 4, cc = j & 15; if (cc < rp + 1) { tl = rp + 1; sl = cc; } else { tl = 15 - rp; sl = cc - (rp + 1); } } else { tl = 8; sl = j - 112; }
                tt = 16 * blk + tl; ss = 16 * blk + sl;
                const LAS float* qp = (const LAS float*)(L + B_QR) + tt * PF + 32 * dh; const LAS float* kp = (const LAS float*)(L + B_KR) + ss * PF + 32 * dh;
                const LAS float* bt = (const LAS float*)(L + B_BC) + tt * PF + 32 * dh; const LAS float* bs = (const LAS float*)(L + B_BC) + ss * PF + 32 * dh;
#pragma unroll 2
                for (int d4 = 0; d4 < 8; ++d4) { const f32x4 q4 = *(const LAS f32x4*)(qp + 4 * d4), k4 = *(const LAS f32x4*)(kp + 4 * d4), b1 = *(const LAS f32x4*)(bt + 4 * d4), b2 = *(const LAS f32x4*)(bs + 4 * d4);
#pragma unroll
                    for (int i = 0; i < 4; ++i) sc += q4[i] * k4[i] * fast_exp2(b1[i] - b2[i]); }
            } else {
                tt = tid - 480; ss = tt;
                const LAS float* qp = (const LAS float*)(L + B_QR) + tt * PF; const LAS float* kp = (const LAS float*)(L + B_KR) + tt * PF;
#pragma unroll 4
                for (int d4 = 0; d4 < 16; ++d4) { const f32x4 q4 = *(const LAS f32x4*)(qp + 4 * d4), k4 = *(const LAS f32x4*)(kp + 4 * d4); sc += (q4[0] * k4[0] + q4[1] * k4[1]) + (q4[2] * k4[2] + q4[3] * k4[3]); }
            }
            const float other = lx<1>(sc);
            if (tid < 480) { if ((tid & 1) == 0) st_bf16(L, B_SC + (tt * PS_ + ss) * 2, sc + other); } else st_bf16(L, B_SC + (tt * PS_ + ss) * 2, sc);
            if (wid == 7) {
                f32x4 acc = {0.f, 0.f, 0.f, 0.f};
#pragma unroll
                for (int kk = 0; kk < 2; ++kk) { const bf16x8 a = *(LAS bf16x8*)(L + B_Q1 + (lr * PD + 8 * lq + 32 * kk) * 2), b = *(LAS bf16x8*)(L + B_K0 + (lr * PD + 8 * lq + 32 * kk) * 2); acc = HG_MFMA(a, b, acc); }
#pragma unroll
                for (int i = 0; i < 4; ++i) st_bf16(L, B_SC + ((16 + 4 * lq + i) * PS_ + lr) * 2, acc[i]);
            }
        }
        HG_SYNC();
        f32x4 o = {0.f, 0.f, 0.f, 0.f};
        {
            const int tm = wid >> 2, vn = wid & 3;
            { const bf16x8 a = *(LAS bf16x8*)(L + B_SC + ((16 * tm + lr) * PS_ + 8 * lq) * 2), b = *(LAS bf16x8*)(L + B_VT + ((16 * vn + lr) * PS_ + 8 * lq) * 2); o = HG_MFMA(a, b, o); }
#pragma unroll
            for (int kk = 0; kk < 2; ++kk) { const bf16x8 a = *(LAS bf16x8*)(L + B_QX + ((16 * tm + lr) * PD + 8 * lq + 32 * kk) * 2), b = *(LAS bf16x8*)(L + B_ST + ((16 * vn + lr) * PD + 8 * lq + 32 * kk) * 2); o = HG_MFMA(a, b, o); }
#pragma unroll
            for (int i = 0; i < 4; ++i) { float s2 = o[i] * o[i]; s2 += lx<1>(s2); s2 += lx<2>(s2); s2 += lx<4>(s2); s2 += lx<8>(s2);
                if (lr == 0) *(LAS float*)(L + B_PS + ((16 * tm + 4 * lq + i) * 4 + vn) * 4) = s2; }
        }
        HG_SYNC();
        { const int tm = wid >> 2, vn = wid & 3;
#pragma unroll
            for (int i = 0; i < 4; ++i) { const int t = 16 * tm + 4 * lq + i; const f32x4 ps = *(LAS f32x4*)(L + B_PS + t * 16);
                const float rs = __builtin_amdgcn_rsqf(((ps[0] + ps[1]) + (ps[2] + ps[3])) * (1.f / 64.f) + EPS); const float gt = *(LAS float*)(L + B_G + (t * PF + 16 * vn + lr) * 4);
                const float y = o[i] * rs * gn4[0] * gt;
                *(bf16_t*)(A.YS + (crow0 + t) * DM + 768 + 64 * h + 16 * vn + lr) = (bf16_t)(cvt_pk_bf16(y, 0.f) & 0xffffu); }
        }
        state_update(L, S, wid, lane, true);
        HG_SYNC();
    }
}
#undef HG_MFMA
#undef HG_SYNC
}

constexpr int N_PHASES = 50;
#ifndef MK_PER_PHASE
#define MK_PER_PHASE 0
#endif
struct KArgs { const float* in[20]; float* out; unsigned char* ws; int ph_lo, ph_hi, li, pad; };

__global__ void __launch_bounds__(NWAVES * 64, 2) fwd(KArgs a) {
    extern __shared__ __attribute__((aligned(16))) unsigned char lds[];
    LAS unsigned char* L = (LAS unsigned char*)lds;
    volatile LAS unsigned* MISC = (volatile LAS unsigned*)(L + MISC_OFF);
    unsigned char* ws = a.ws;
    const int wv = __builtin_amdgcn_readfirstlane((int)threadIdx.x >> 6);
    for (int u = (wv << 6) | lane_id(); u < (LDS_BYTES - LDSCTL_OFF) / 4; u += NWAVES * 64) ((LAS unsigned*)(L + LDSCTL_OFF))[u] = 0u;
    __syncthreads();
    XcdBarrier bar = xcd_barrier_post((unsigned*)(ws + WS_CTL) + CW_BAR + a.li * XCD_BAR_WORDS, MISC + 8, wv == 0 && lane_id() == 0);
    const int lo = a.ph_lo, hi = a.ph_hi;
#ifndef EN_MASK
#define EN_MASK 0xFFFFFFFFu
#endif
#define EN(b) ((EN_MASK >> (b)) & 1u)
#define IN(k) (lo <= (k) && (k) < hi)
#define SEAM(k) do { if (IN(k) && IN((k) + 1)) xcd_barrier(bar, wv == 0 && lane_id() == 0); } while (0)
#define DEFPTRS const __attribute__((address_space(4))) KArgs* ka = (const __attribute__((address_space(4))) KArgs*)__builtin_amdgcn_kernarg_segment_ptr(); asm volatile("" : "+s"(ka)); unsigned char* wsl = ka->ws; int tid = (wv << 6) | lane_id(); asm volatile("" : "+v"(tid)); const int lane = tid & 63, wave = wv; int bxl = blockIdx.x; asm volatile("" : "+s"(bxl)); const int G = gridDim.x; const int vcu = (G % 8 == 0) ? (bxl % 8) * (G / 8) + bxl / 8 : bxl; const int gw = vcu * NWAVES + wave, NGW = G * NWAVES; (void)lane; (void)gw; (void)NGW; float* SQ = (float*)(wsl + WS_SQ); float* ROPEC = (float*)(wsl + WS_ROPE); float* ROPES = ROPEC + SEQ * 16; float* LF = (float*)(wsl + WS_LF); bf16_t* KX = (bf16_t*)(wsl + WS_KX); float* TBA = (float*)(wsl + WS_TB); float* KMXA = TBA + 32 * 128; float* K2P = (float*)(wsl + WS_K2P); float* SLOC = (float*)(wsl + WS_HGS); float* LSEG = SLOC + (size_t)1024 * 4096; bf16_t* W = (bf16_t*)(wsl + WS_W); bf16_t* PB = (bf16_t*)(wsl + WS_PB); bf16_t* XB = (bf16_t*)(wsl + WS_XB); bf16_t* XBA = (bf16_t*)(wsl + WS_BIG + BIG_QM); bf16_t* YS = (bf16_t*)(wsl + WS_YS); bf16_t* MIX = (bf16_t*)(wsl + WS_BIG + BIG_MIX); bf16_t* QM = (bf16_t*)(wsl + WS_BIG + BIG_QM); bf16_t* KN = (bf16_t*)(wsl + WS_BIG + BIG_KN); bf16_t* VM = (bf16_t*)(wsl + WS_BIG + BIG_VM); bf16_t* KR = (bf16_t*)(wsl + WS_BIG + BIG_KR); bf16_t* PBUF = (bf16_t*)(wsl + WS_BIG); unsigned char* H8 = wsl + WS_BIG; unsigned char* X8 = wsl + WS_X8; unsigned char* X8B = wsl + WS_BIG + 192 * MiB; float* X = ka->out;

    if (EN(0) && IN(0)) { DEFPTRS;
        for (int idx = gw * 64 + lane; idx < SEQ * 16; idx += NGW * 64) {
            const int pos = idx >> 4, i = idx & 15;
            const double inv = exp2(-(double)i * (13.287712379549449 / 16.0));
            const double ang = (double)pos * inv;
            const double kq = rint(ang * 0.6366197723675814); const double y = fma(-kq, 1.5707963267948966, ang) - kq * 6.123233995736766e-17; const double y2 = y * y;
            const double sy = y * (1.0 + y2 * (-1.0 / 6 + y2 * (1.0 / 120 + y2 * (-1.0 / 5040 + y2 * (1.0 / 362880 + y2 * (-1.0 / 39916800 + y2 * (1.0 / 6227020800.0)))))));
            const double cy = 1.0 + y2 * (-0.5 + y2 * (1.0 / 24 + y2 * (-1.0 / 720 + y2 * (1.0 / 40320 + y2 * (-1.0 / 3628800 + y2 * (1.0 / 479001600.0))))));
            const int qd = ((int)((long long)kq & 3));
            const double sn = (qd == 0) ? sy : (qd == 1) ? cy : (qd == 2) ? -sy : -cy, cs = (qd == 0) ? cy : (qd == 1) ? -sy : (qd == 2) ? -cy : sy;
            ROPEC[idx] = (float)cs; ROPES[idx] = (float)sn;
        }
        const float* xin = ka->in[0];
        for (int row = gw; row < NTOK; row += 2 * NGW) {
            f32x4 v[2][4];
#pragma unroll
            for (int q = 0; q < 2; ++q)
#pragma unroll
                for (int j = 0; j < 4; ++j) v[q][j] = ((const f32x4*)(xin + (size_t)(row + q * NGW) * DM) + lane)[64 * j];
#pragma unroll
            for (int q = 0; q < 2; ++q) { const int r = row + q * NGW; unsigned long long* o8 = (unsigned long long*)(XBA + (size_t)r * DM) + lane; float s = 0.f;
#pragma unroll
                for (int j = 0; j < 4; ++j) { const f32x4 w = v[q][j]; s += (w[0] * w[0] + w[1] * w[1]) + (w[2] * w[2] + w[3] * w[3]);
                    const unsigned w0 = cvt_pk_bf16(w[0], w[1]), w1 = cvt_pk_bf16(w[2], w[3]); o8[64 * j] = (unsigned long long)w0 | ((unsigned long long)w1 << 32);
                    ((unsigned*)(X8 + (size_t)r * DM) + lane)[64 * j] = pk_fp8x4(bf_lo(w0), bf_hi(w0), bf_lo(w1), bf_hi(w1)); }
                s = wave_sum(s); if (lane < 16) SQ[(size_t)r * 16 + lane] = (lane == 0) ? s : 0.f; }
        }
    }
    SEAM(0);

    for (int layer = 0; layer < DEPTH; ++layer) {
        const int pb = 1 + 12 * layer;
#define LAYERPTRS const float* norms = ka->in[18] + (size_t)layer * 4 * DM; float* sq0 = SQ; float* sq1 = SQ + (size_t)1 * NTOK * 16; float* sq2 = SQ + (size_t)2 * NTOK * 16; float* sq3 = SQ + (size_t)3 * NTOK * 16; float* sq4 = SQ; float* sqq = SQ + (size_t)4 * NTOK * 16; float* sqkv = sqq + (size_t)NTOK * 4; (void)sq0; (void)sq1; (void)sq2; (void)sq3; (void)sq4; (void)sqq; (void)sqkv; (void)norms;

        if (EN(1) && IN(pb + 0)) { DEFPTRS; LAYERPTRS;
            ConvCtx C; C.scr = (LAS float*)(L + wave * 16384); C.gw = gw; C.NGW = NGW; C.lane = lane; C.base = 0;
            conv_mat8(C, ka->in[12] + (size_t)layer * DM * 2 * FF, 2 * FF, DM, 2 * FF, norms + 0 * DM, (unsigned char*)(W + WO_FA1), MK_FFN1, 64.f);
            conv_mat8(C, ka->in[13] + (size_t)layer * FF * DM, DM, FF, DM, nullptr, (unsigned char*)(W + WO_FA2), MK_ID, 128.f);
            conv_mat8(C, ka->in[14] + (size_t)layer * DM * 2 * FF, 2 * FF, DM, 2 * FF, norms + 2 * DM, (unsigned char*)(W + WO_FB1), MK_FFN1, 64.f);
            conv_mat8(C, ka->in[15] + (size_t)layer * FF * DM, DM, FF, DM, nullptr, (unsigned char*)(W + WO_FB2), MK_ID, 128.f);
            conv_mat8(C, ka->in[2] + (size_t)layer * DM * INCOLS, INCOLS, DM, NMIX, norms + 1 * DM, (unsigned char*)(W + WO_MIX), MK_MIX, 64.f);
            conv_mat8(C, ka->in[2] + (size_t)layer * DM * INCOLS, INCOLS, DM, NGATE, norms + 1 * DM, (unsigned char*)(W + WO_GATE), MK_GATE, 64.f);
            conv_mat(C, ka->in[5] + (size_t)layer * 256 * 384, 384, 256, 256, 512, ka->in[4] + layer * 256, W + WO_UQ, MK_UQ);
            conv_mat(C, ka->in[7] + (size_t)layer * 128 * 512, 512, 128, 256, 512, ka->in[6] + layer * 128, W + WO_UKV, MK_ID);
            for (int nb = 0; nb < 4; ++nb) conv_mat(C, ka->in[10] + ((size_t)layer * 4 + nb) * 256 * DM, DM, 256, 256, DM, nullptr, W + WO_BR + (size_t)nb * DM * 256, MK_ID);
            conv_mat8(C, ka->in[11] + (size_t)layer * DM * DM, DM, DM, DM, nullptr, (unsigned char*)(W + WO_OUT), MK_ID, 64.f);
            conv_mat8(C, ka->in[17] + (size_t)layer * DM * DM, DM, DM, DM, norms + 3 * DM, (unsigned char*)(W + WO_PG), MK_ID, 64.f);
            conv_mat(C, ka->in[16] + (size_t)layer * PLE * DM, DM, PLE, PLE, DM, nullptr, W + WO_PE, MK_ID);
            const f32x4* ps = (const f32x4*)(ka->in[1] + (size_t)layer * NTOK * PLE); u32x2* pd = (u32x2*)PB;
            for (int i = gw * 64 + lane; i < NTOK * PLE / 4; i += NGW * 64) { const f32x4 v = ps[i]; u32x2 w; w.x = cvt_pk_bf16(v[0], v[1]); w.y = cvt_pk_bf16(v[2], v[3]); pd[i] = w; }
            LDS_WAIT(); __syncthreads();
        }
        SEAM(pb + 0);

        if (EN(2) && IN(pb + 1)) { DEFPTRS; LAYERPTRS;
            pg8::Gemm g{(const bf16_t*)X8, W + WO_FA1, NTOK, 2 * FF, DM / 2, DM / 2, DM / 2, 0, 0, 127, 121}; pg8::StaticOrder S; S.init(NTOK, 2 * FF, G, bxl);
            pg8::EpiSwiglu E{H8, sq0, (LAS const float*)(L + pg8::RS_TAB_OFF)}; pg8::gemm_phase<pg8::EpiSwiglu, true>(L, g, S, E, wv);
        }
        SEAM(pb + 1);
        if (EN(3) && IN(pb + 2)) { DEFPTRS; LAYERPTRS;
            pg8::Gemm g{(const bf16_t*)H8, W + WO_FA2, NTOK, DM, FF / 2, FF / 2, FF / 2, 0, 0, 124, 120}; pg8::StaticOrder S; S.init(NTOK, DM, G, bxl, 1);
            pg8::EpiResid E{XBA, XB, sq1, 0.5f, X8, (LAS unsigned char*)(L + pg8::STG_OFF)}; pg8::gemm_phase<pg8::EpiResid, true>(L, g, S, E, wv);
        }
        SEAM(pb + 2);
        if (EN(4) && IN(pb + 3)) { DEFPTRS; LAYERPTRS;
            pg8::Gemm g{(const bf16_t*)X8, W + WO_MIX, NTOK, NMIX, DM / 2, DM / 2, DM / 2, 0, 0, 127, 121}; pg8::StaticOrder S; S.init(NTOK, NMIX, G, bxl);
            pg8::EpiMix E{MIX, sq1, sqq, sqkv, KR, LF, ROPEC, ROPES, ka->in[3] + layer * 4, K2P, (LAS const float*)(L + pg8::RS_TAB_OFF)}; pg8::gemm_phase<pg8::EpiMix, true>(L, g, S, E, wv);
        }
        SEAM(pb + 3);
        if (EN(5) && IN(pb + 4)) { DEFPTRS; LAYERPTRS;
            if (EN(16) && wave == 0) for (int sg = vcu; sg < 256; sg += G) {
                const int bh = sg >> 3, seg = sg & 7, b = bh >> 2, h = bh & 3; float carry = 0.f, kmax = 0.f;
                { float a0 = 0.f, a1 = 0.f, m0 = 0.f, m1 = 0.f;
                  for (int i = lane; i < seg * 1024; i += 128) { const size_t r0 = (size_t)b * SEQ + i, r1 = r0 + 64;
                      a0 += LF[r0 * 4 + h]; a1 += LF[r1 * 4 + h]; const f32x2 k0 = *(const f32x2*)(K2P + r0 * 8 + 2 * h), k1 = *(const f32x2*)(K2P + r1 * 8 + 2 * h); m0 = fmaxf(m0, k0[0] + k0[1]); m1 = fmaxf(m1, k1[0] + k1[1]); }
                  carry = wave_sum(a0 + a1); kmax = fmaxf(m0, m1);
                  kmax = wave_max(kmax); }
                for (int c = seg * 16; c < seg * 16 + 16; ++c) { const size_t row = (size_t)b * SEQ + 64 * c + lane; float v = LF[row * 4 + h];
#pragma unroll
                    for (int off = 1; off < 64; off <<= 1) { const float y = bperm(v, lane - off); if (lane >= off) v += y; }
                    v += carry; const float cref = __uint_as_float((unsigned)__builtin_amdgcn_readlane((int)__float_as_uint(v), 63)); carry = cref;
                    const float bias = (cref - v) * LOG2E; const unsigned hb = cvt_pk_bf16(bias, 0.f) & 0xffffu; const float hf = __uint_as_float(hb << 16); const unsigned lb = cvt_pk_bf16(bias - hf, 0.f) & 0xffffu;
                    *(u32x4*)(KX + ((size_t)bh * SEQ + 64 * c + lane) * 8) = (u32x4){hb | (lb << 16), 0u, 0u, 0u};
                    const f32x2 kk = *(const f32x2*)(K2P + row * 8 + 2 * h); float k2 = kk[0] + kk[1];
                    k2 = wave_max(k2);
                    kmax = fmaxf(kmax, k2);
                    if (lane == 0) { TBA[bh * 128 + c] = -cref * LOG2E; KMXA[bh * 128 + c] = sqrtf(kmax) * 1.0001f; } }
            }
            if (EN(17)) { pg8::Gemm g{MIX + MX_MCQ, W + WO_UQ, NTOK, 1024, 256, NMIX, 256, 1, MX_T4 - MX_MCQ, 0, 0}; pg8::StaticOrder S; S.init(NTOK, 1024, G, bxl, 1);
              pg8::EpiQKVup E{{QM, sqq, ROPEC, ROPES}, {KN, VM, sqkv}}; pg8::gemm_phase(L, g, S, E, wv); }
            if (EN(19)) { hg::Args HA{MIX, ka->in[8], ka->in[9] + layer * 256, SLOC, LSEG, YS, layer};
              for (int u = vcu; u < 1024; u += G) hg::stage1_unit(L, HA, u >> 5, u & 31, wv); }
        }
        SEAM(pb + 4);
        if (EN(6) && IN(pb + 5)) { DEFPTRS; LAYERPTRS;
#define UNIT_OF(idx, bh, qb) const int quarter_ = (idx) >> 8, rem_ = (idx) & 255, s_ = rem_ & 7; const int g_ = rem_ >> 3; const int bh = (g_ & ~3) | ((g_ + quarter_) & 3), qb = quarter_ == 0 ? s_ : quarter_ == 1 ? 15 - s_ : quarter_ == 2 ? 16 + s_ : 31 - s_;
            if (EN(20)) { const att::Args A{MIX + MX_FQ, NMIX, 64, MIX + MX_FK, NMIX, KX, MIX + MX_FV, NMIX, TBA, KMXA, YS + 0};
              for (int idx = vcu; idx < 1024; idx += G) { UNIT_OF(idx, bh, qb); att::attn_unit<att::FOX>((char*)lds, bh >> 2, bh & 3, qb, A, wv); } }
            if (EN(21)) { const att::Args A{QM, 384, 96, KN, 256, KR, VM, 256, nullptr, nullptr, YS + 256};
              for (int idx = vcu; idx < 1024; idx += G) { UNIT_OF(idx, bh, qb); att::attn_unit<att::MLA>((char*)lds, bh >> 2, bh & 3, qb, A, wv); } }
            if (EN(22)) { const att::Args A{MIX + MX_SQ, NMIX, 64, MIX + MX_SK, NMIX, nullptr, MIX + MX_SV, NMIX, nullptr, nullptr, YS + 512};
              for (int idx = vcu; idx < 1024; idx += G) { UNIT_OF(idx, bh, qb); att::attn_unit<att::SB>((char*)lds, bh >> 2, bh & 3, qb, A, wv); } }
            if (EN(23)) { hg::Args HA{MIX, ka->in[8], ka->in[9] + layer * 256, SLOC, LSEG, YS, layer};
              for (int u = vcu; u < 1024; u += G) hg::stage2_unit(L, HA, u >> 5, u & 31, wv); }
#undef UNIT_OF
        }
        SEAM(pb + 5);
        if (EN(7) && IN(pb + 6)) { DEFPTRS; LAYERPTRS;
            pg8::Gemm g{YS, W + WO_BR, NTOK, NGATE, 256, DM, 256, 2, 256, 0, 0}; pg8::StaticOrder S; S.init(NTOK, NGATE, G, bxl);
            pg8::EpiPnat E{(unsigned*)PBUF}; pg8::gemm_phase(L, g, S, E, wv);
        }
        SEAM(pb + 6);
        if (EN(8) && IN(pb + 7)) { DEFPTRS; LAYERPTRS;
            pg8::Gemm g{(const bf16_t*)X8, W + WO_GATE, NTOK, NGATE, DM / 2, DM / 2, DM / 2, 0, 0, 127, 121}; pg8::StaticOrder S; S.init(NTOK, NGATE, G, bxl, 1);
            pg8::EpiGate E{(unsigned char*)YS, (const unsigned*)PBUF, sq1, (LAS const float*)(L + pg8::RS_TAB_OFF)}; pg8::gemm_phase<pg8::EpiGate, true>(L, g, S, E, wv);
        }
        SEAM(pb + 7);
        if (EN(9) && IN(pb + 8)) { DEFPTRS; LAYERPTRS;
            pg8::Gemm g{YS, W + WO_OUT, NTOK, DM, DM / 2, DM / 2, DM / 2, 0, 0, 124, 121}; pg8::StaticOrder S; S.init(NTOK, DM, G, bxl);
            pg8::EpiResid E{XB, XB, sq2, 1.0f, X8, (LAS unsigned char*)(L + pg8::STG_OFF)}; pg8::gemm_phase<pg8::EpiResid, true>(L, g, S, E, wv);
        }
        SEAM(pb + 8);
        if (EN(10) && IN(pb + 9)) { DEFPTRS; LAYERPTRS;
            { pg8::Gemm g{(const bf16_t*)X8, W + WO_FB1, NTOK, 2 * FF, DM / 2, DM / 2, DM / 2, 0, 0, 127, 121}; pg8::StaticOrder S; S.init(NTOK, 2 * FF, G, bxl, 1);
              pg8::EpiSwiglu E{H8, sq2, (LAS const float*)(L + pg8::RS_TAB_OFF)}; pg8::gemm_phase<pg8::EpiSwiglu, true>(L, g, S, E, wv); }
            { pg8::Gemm g{PB, W + WO_PE, NTOK, DM, PLE, PLE, PLE, 0, 0, 0, 0}; pg8::StaticOrder S; S.init(NTOK, DM, G, bxl, 1);
              pg8::EpiBf16<DM> E{YS}; pg8::gemm_phase(L, g, S, E, wv); }
        }
        SEAM(pb + 9);
        if (EN(11) && IN(pb + 10)) { DEFPTRS; LAYERPTRS;
            pg8::Gemm g{(const bf16_t*)H8, W + WO_FB2, NTOK, DM, FF / 2, FF / 2, FF / 2, 0, 0, 124, 120}; pg8::StaticOrder S; S.init(NTOK, DM, G, bxl);
            pg8::EpiResid E{XB, XB, sq3, 0.5f, X8B, (LAS unsigned char*)(L + pg8::STG_OFF)}; pg8::gemm_phase<pg8::EpiResid, true>(L, g, S, E, wv);
        }
        SEAM(pb + 10);
        if (EN(12) && IN(pb + 11)) { DEFPTRS; LAYERPTRS;
            pg8::Gemm g{(const bf16_t*)X8B, W + WO_PG, NTOK, DM, DM / 2, DM / 2, DM / 2, 0, 0, 127, 121}; pg8::StaticOrder S; S.init(NTOK, DM, G, bxl, 1);
            pg8::EpiPle E{XB, XBA, YS, sq3, sq4, X8, (LAS const float*)(L + pg8::RS_TAB_OFF), (LAS unsigned char*)(L + pg8::STG_OFF)}; pg8::gemm_phase<pg8::EpiPle, true>(L, g, S, E, wv);
        }
        SEAM(pb + 11);
    }
    if (EN(13) && IN(49)) { DEFPTRS;
        const float* fn = ka->in[19]; const float* sqf = SQ;
        f32x4 gq[4];
#pragma unroll
        for (int j = 0; j < 4; ++j) gq[j] = ((const f32x4*)fn + lane)[64 * j];
        for (int row = gw; row < NTOK; row += 4 * NGW) {
            float rs[4]; u32x2 w[4][4];
#pragma unroll
            for (int q = 0; q < 4; ++q) { rs[q] = rstd16(sqf, row + q * NGW); const u32x2* xs = (const u32x2*)(XBA + (size_t)(row + q * NGW) * DM) + lane;
#pragma unroll
                for (int j = 0; j < 4; ++j) w[q][j] = xs[64 * j]; }
#pragma unroll
            for (int q = 0; q < 4; ++q) { f32x4* xr = (f32x4*)(X + (size_t)(row + q * NGW) * DM) + lane;
#pragma unroll
                for (int j = 0; j < 4; ++j) { const f32x4 v = {bf_lo(w[q][j].x), bf_hi(w[q][j].x), bf_lo(w[q][j].y), bf_hi(w[q][j].y)}; xr[64 * j] = v * rs[q] * gq[j]; } }
        }
    }
#undef IN
#undef SEAM
}

extern "C" void kernel_launch(void* const* d_in, const int* in_sizes, int n_in, void* d_out, int out_size, void* d_ws, size_t ws_size, hipStream_t stream) {
    static int grid = 0;
    if (grid == 0) {
        if (n_in != 20 || out_size != NTOK * DM || ws_size < WS_END) { fprintf(stderr, "kernel_launch: unexpected shapes (n_in %d, out %d, ws %zu)\n", n_in, out_size, ws_size); grid = -1; return; }
        int dev = 0, cus = 0, per_cu = 0;
        if (hipGetDevice(&dev) != hipSuccess || hipDeviceGetAttribute(&cus, hipDeviceAttributeMultiprocessorCount, dev) != hipSuccess) { grid = -1; return; }
        if (hipFuncSetAttribute((const void*)fwd, hipFuncAttributeMaxDynamicSharedMemorySize, LDS_BYTES) != hipSuccess) { fprintf(stderr, "kernel_launch: hipFuncSetAttribute failed\n"); grid = -1; return; }
        if (hipOccupancyMaxActiveBlocksPerMultiprocessor(&per_cu, (const void*)fwd, NWAVES * 64, LDS_BYTES) != hipSuccess || per_cu < 1) { fprintf(stderr, "kernel_launch: occupancy query says %d\n", per_cu); }
        (void)hipGetLastError();
        grid = cus;
    }
    if (grid < 0) return;
    if (hipMemsetAsync((char*)d_ws + WS_CTL, 0, CTL_ZERO_BYTES, stream) != hipSuccess) return;
    KArgs a{};
    for (int i = 0; i < 20; ++i) a.in[i] = (const float*)d_in[i];
    a.out = (float*)d_out; a.ws = (unsigned char*)d_ws; a.pad = 0;
#if MK_PER_PHASE
    for (int ph = 0; ph < N_PHASES; ++ph) { a.ph_lo = ph; a.ph_hi = ph + 1; a.li = ph; hipLaunchKernelGGL(fwd, dim3(grid), dim3(NWAVES * 64), LDS_BYTES, stream, a); }
#else
    a.ph_lo = 0; a.ph_hi = N_PHASES; a.li = 0;
    hipLaunchKernelGGL(fwd, dim3(grid), dim3(NWAVES * 64), LDS_BYTES, stream, a);
#endif
}
```

```cpp
#include <hip/hip_runtime.h>
#include <hip/hip_bf16.h>
#include <cstdio>
#include <cstdint>
#include <cmath>

#define LAS __attribute__((address_space(3)))
#define GAS __attribute__((address_space(1)))
typedef unsigned short bf16_t;
typedef short bf16x8 __attribute__((ext_vector_type(8)));
typedef short s16x4 __attribute__((ext_vector_type(4)));
typedef float f32x4 __attribute__((ext_vector_type(4)));
typedef float f32x2 __attribute__((ext_vector_type(2)));
typedef float f32x16 __attribute__((ext_vector_type(16)));
typedef unsigned u32x4 __attribute__((ext_vector_type(4)));
typedef unsigned u32x2 __attribute__((ext_vector_type(2)));

constexpr int NTOK = 65536, DM = 1024, SEQ = 8192, NBATCH = 8, DEPTH = 4, FF = 2816, PLE = 256;
constexpr int NMIX = 3072, NGATE = 4096, INCOLS = 7076;
constexpr float EPS = 1e-6f, LOG2E = 1.4426950408889634f, LN2 = 0.6931471805599453f;
constexpr int MX_FQ = 0, MX_FK = 256, MX_FV = 512, MX_MCQ = 768, MX_T4 = 1024, MX_SQ = 1280, MX_SK = 1536, MX_SV = 1792, MX_HQ = 2048, MX_HF = 2304, MX_HI = 2560, MX_HG = 2816;

__device__ __forceinline__ unsigned cvt_pk_bf16(float lo, float hi) { typedef __bf16 bf16x2_t __attribute__((ext_vector_type(2))); f32x2 v = {lo, hi}; bf16x2_t b = __builtin_convertvector(v, bf16x2_t); return __builtin_bit_cast(unsigned, b); }
__device__ __forceinline__ unsigned cvt_pk_bf16_v(float lo, float hi) { unsigned r; asm volatile("v_cvt_pk_bf16_f32 %0, %1, %2" : "=v"(r) : "v"(lo), "v"(hi)); return r; }
__device__ __forceinline__ int lane_id() { return (int)__builtin_amdgcn_mbcnt_hi(~0u, __builtin_amdgcn_mbcnt_lo(~0u, 0u)); }
#define DPPF(v, ctrl) __uint_as_float((unsigned)__builtin_amdgcn_update_dpp(0, (int)__float_as_uint(v), ctrl, 0xf, 0xf, false))
template <int M> __device__ __forceinline__ float lx(float x) {
    if constexpr (M == 1) return DPPF(x, 0xB1);
    else if constexpr (M == 2) return DPPF(x, 0x4E);
    else return __uint_as_float((unsigned)__builtin_amdgcn_ds_swizzle((int)__float_as_uint(x), (M << 10) | 0x1F)); }
__device__ __forceinline__ float row16_sum(float v) { v += DPPF(v, 0xB1); v += DPPF(v, 0x4E); v += DPPF(v, 0x124); v += DPPF(v, 0x128); return v; }
__device__ __forceinline__ float row16_max(float v) { v = fmaxf(v, DPPF(v, 0xB1)); v = fmaxf(v, DPPF(v, 0x4E)); v = fmaxf(v, DPPF(v, 0x124)); v = fmaxf(v, DPPF(v, 0x128)); return v; }
__device__ __forceinline__ float x16_sum(float x) { auto rr = __builtin_amdgcn_permlane16_swap(__float_as_uint(x), __float_as_uint(x), false, false); return __uint_as_float(rr[0]) + __uint_as_float(rr[1]); }
__device__ __forceinline__ float x16_max(float x) { auto rr = __builtin_amdgcn_permlane16_swap(__float_as_uint(x), __float_as_uint(x), false, false); return fmaxf(__uint_as_float(rr[0]), __uint_as_float(rr[1])); }
__device__ __forceinline__ float x32_sum(float x) { auto rr = __builtin_amdgcn_permlane32_swap(__float_as_uint(x), __float_as_uint(x), false, false); return __uint_as_float(rr[0]) + __uint_as_float(rr[1]); }
__device__ __forceinline__ float x32_max(float x) { auto rr = __builtin_amdgcn_permlane32_swap(__float_as_uint(x), __float_as_uint(x), false, false); return fmaxf(__uint_as_float(rr[0]), __uint_as_float(rr[1])); }
__device__ __forceinline__ float x32_other(float x, int hi) { auto rr = __builtin_amdgcn_permlane32_swap(__float_as_uint(x), __float_as_uint(x), false, false); return __uint_as_float(hi ? rr[0] : rr[1]); }
__device__ __forceinline__ u32x4 widen16(u32x2 a, u32x2 b) { auto rx = __builtin_amdgcn_permlane16_swap(a.x, b.x, false, false); auto ry = __builtin_amdgcn_permlane16_swap(a.y, b.y, false, false); return (u32x4){rx[0], ry[0], rx[1], ry[1]}; }
__device__ __forceinline__ float bperm(float x, int src_lane) { return __uint_as_float((unsigned)__builtin_amdgcn_ds_bpermute(src_lane << 2, (int)__float_as_uint(x))); }
__device__ __forceinline__ float wave_sum(float v) { return x32_sum(x16_sum(row16_sum(v))); }
__device__ __forceinline__ float wave_max(float v) { return x32_max(x16_max(row16_max(v))); }
__device__ __forceinline__ float clamp8(float v) { return __builtin_amdgcn_fmed3f(v, -448.f, 448.f); }
__device__ __forceinline__ unsigned pk_fp8x4(float a, float b, float c, float d) { int p = __builtin_amdgcn_cvt_pk_fp8_f32(a, b, 0, false); p = __builtin_amdgcn_cvt_pk_fp8_f32(c, d, p, true); return (unsigned)p; }
__device__ __forceinline__ float bf_lo(unsigned w) { return __uint_as_float(w << 16); }
__device__ __forceinline__ float bf_hi(unsigned w) { return __uint_as_float(w & 0xffff0000u); }
__device__ __forceinline__ float fast_exp2(float x) { return __builtin_amdgcn_exp2f(x); }
__device__ __forceinline__ float fast_log2(float x) { return __builtin_amdgcn_logf(x); }
__device__ __forceinline__ float fast_rcp(float x) { return __builtin_amdgcn_rcpf(x); }
__device__ __forceinline__ float sigmoidf_(float x) { return fast_rcp(1.f + fast_exp2(-x * LOG2E)); }
__device__ __forceinline__ float rstd16(const float* ps, int row) { const f32x4* p = (const f32x4*)(ps + (size_t)row * 16); const f32x4 a = p[0], b = p[1], c = p[2], d = p[3];
    const f32x4 t = (a + b) + (c + d); return __builtin_amdgcn_rsqf(((t[0] + t[1]) + (t[2] + t[3])) * (1.f / 1024.f) + 1e-6f); }
__device__ __forceinline__ float rstd4(const float* ps, int row, float inv_n) { const f32x4 t = *(const f32x4*)(ps + (size_t)row * 4); return __builtin_amdgcn_rsqf(((t[0] + t[1]) + (t[2] + t[3])) * inv_n + 1e-6f); }
__device__ __forceinline__ void rstd16_rows(const float* ps, int row0, float (&rs)[8]) {
#pragma unroll
    for (int h = 0; h < 4; ++h) { f32x4 t[2][4];
#pragma unroll
        for (int m = 0; m < 2; ++m) { const int k = 2 * h + m; const f32x4* p = (const f32x4*)(ps + (size_t)(row0 + (k >> 2) * 128 + (k & 3) * 16) * 16);
#pragma unroll
            for (int j = 0; j < 4; ++j) t[m][j] = p[j]; }
#pragma unroll
        for (int m = 0; m < 2; ++m) { const f32x4 s = (t[m][0] + t[m][1]) + (t[m][2] + t[m][3]); rs[2 * h + m] = __builtin_amdgcn_rsqf(((s[0] + s[1]) + (s[2] + s[3])) * (1.f / 1024.f) + 1e-6f); }
        asm volatile("" : "+v"(row0) : "v"(rs[2 * h]), "v"(rs[2 * h + 1]) : "memory"); }
}
__device__ __forceinline__ void rstd4_rows(const float* ps, int row0, float inv_n, float (&rs)[8]) {
    f32x4 t[8];
#pragma unroll
    for (int k = 0; k < 8; ++k) t[k] = *(const f32x4*)(ps + (size_t)(row0 + (k >> 2) * 128 + (k & 3) * 16) * 4);
#pragma unroll
    for (int k = 0; k < 8; ++k) rs[k] = __builtin_amdgcn_rsqf(((t[k][0] + t[k][1]) + (t[k][2] + t[k][3])) * inv_n + 1e-6f);
}
__device__ __forceinline__ f32x2 sig2_t(f32x2 t) { f32x2 e; e.x = fast_exp2(t.x); e.y = fast_exp2(t.y); const f32x2 d = e + 1.0f; f32x2 r; r.x = fast_rcp(d.x); r.y = fast_rcp(d.y); return r; }
__device__ __forceinline__ float rstd_from(float sumsq, float inv_n) { return __builtin_amdgcn_rsqf(sumsq * inv_n + EPS); }

namespace pg8 {
constexpr int BM = 256, BK = 64, HALF = 128, HTB = HALF * BK * 2  , STAGE_BYTES = 8 * HTB, NXCD = 8, WGM = 8;
__host__ __device__ __forceinline__ int lds_byte(int r, int c) { const int st = (r >> 4) * 2 + (c >> 5), rr = r & 15, cc = c & 31, ob = rr * 64 + cc * 2; return st * 1024 + (ob ^ (((ob >> 9) & 1) << 5)); }
__host__ __device__ __forceinline__ void stage_rc(int b, int& R, int& C) { const int st = b / 1024, sb = b % 1024, swz = sb ^ (((sb >> 9) & 1) << 5); R = (st >> 1) * 16 + swz / 64; C = (st & 1) * 32 + (swz % 64) / 2; }
__host__ __device__ __forceinline__ int perm32(int rho) { const int n = rho >> 4, i = rho & 15; return 8 * (i >> 2) + 4 * n + (i & 3); }

struct Unit { int pm, pn, ord; };
constexpr int RS_TAB_OFF = 131072 + 2048, RS_TAB_UNITS = 24, STG_OFF = RS_TAB_OFF + 4096, STG_WAVE = 3328, STG_PITCH = 144, STG_X8 = 2304;
struct Gemm { const bf16_t* A; const bf16_t* Bt; int M, N, K, lda, ldb, a_shift, a_goff; int sx, sw; };

struct StaticOrder {
    int nM, nN, nwg, G, c, rev;
    __host__ __device__ void init(int M, int N, int G_, int c_, int rev_ = 0) { nM = M / BM; nN = N / BM; nwg = nM * nN; G = G_; c = c_; rev = rev_; }
    __host__ __device__ bool next(int i, Unit& u) const {
        const long L = (long)i * G + c; if (L >= nwg) return false;
        int wgid = (int)L; { const int q = nwg / NXCD, r = nwg % NXCD, xcd = wgid % NXCD, off = wgid / NXCD; wgid = (xcd < r ? xcd * (q + 1) : r * (q + 1) + (xcd - r) * q) + off; }
        const int nig = WGM * nN, gid = wgid / nig, fm = gid * WGM, gsz = (nM - fm) < WGM ? (nM - fm) : WGM;
        u.pm = fm + ((wgid % nig) % gsz); u.pn = (wgid % nig) / gsz; if (rev) { const int blk = nM / NXCD; u.pm = (nM % NXCD == 0) ? (u.pm / blk) * blk + (blk - 1 - u.pm % blk) : nM - 1 - u.pm; }
        return true;
    }
};

typedef int v4i_t __attribute__((ext_vector_type(4)));
typedef int v8i_t __attribute__((ext_vector_type(8)));
template <class Epi, bool F8 = false>
__device__ __forceinline__ void gemm_phase(LAS unsigned char* lds, const Gemm g, const StaticOrder& S, const Epi& E, const int wv) {
    int tid_ = (wv << 6) | lane_id(); asm volatile("" : "+v"(tid_));
    const int tid = tid_, wid = __builtin_amdgcn_readfirstlane(tid >> 6), lane = tid & 63, wr = wid >> 2, wc = wid & 3, fr = lane & 15, fq = lane >> 4;
    const int K = g.K, nt = K / BK;
    unsigned voffA[2], voffB[2];
#pragma unroll
    for (int i = 0; i < 2; ++i) { int R, C; stage_rc(tid * 16 + i * 8192, R, C); const int Rb = Epi::CMAP ? (64 * (R >> 5) + perm32(R & 31)) : Epi::PERM ? ((R & ~31) + perm32(R & 31)) : R;
        voffA[i] = (unsigned)(R * g.lda + C) * 2u; voffB[i] = (unsigned)(Rb * g.ldb + C) * 2u; }
    const size_t kstep = (size_t)(BK * 2);
    const size_t hstepA = (size_t)HALF * g.lda * 2, hstepB = (size_t)(Epi::CMAP ? 32 : HALF) * g.ldb * 2;
    const size_t tstepA = 2 * hstepA, tstepB = (size_t)BM * g.ldb * 2;
    const unsigned ldsw = (unsigned)wid * 1024u;
    const int aoff = lds_byte(wr * 64 + fr, fq * 8), boff = lds_byte(wc * 32 + fr, fq * 8);
#define PG8_SA(b, h) (((b) * 2 + (h)) * HTB)
#define PG8_SB(b, h) ((4 + (b) * 2 + (h)) * HTB)
#define PG8_STAGE(bufoff, gbase, voff) do { _Pragma("unroll") for (int _i = 0; _i < 2; ++_i) \
        __builtin_amdgcn_global_load_lds((const unsigned*)((const char*)(gbase) + (voff)[_i]), (LAS unsigned*)(lds + (bufoff) + ldsw + _i * 8192), 16, 0, 0); } while (0)
#define PG8_LDA(dst, b, h) do { _Pragma("unroll") for (int m = 0; m < 4; ++m) _Pragma("unroll") for (int k = 0; k < 2; ++k) dst[m][k] = *(const LAS bf16x8*)(lds + PG8_SA(b, h) + aoff + m * 2048 + k * 1024); } while (0)
#define PG8_LDB(dst, b, h) do { _Pragma("unroll") for (int n = 0; n < 2; ++n) _Pragma("unroll") for (int k = 0; k < 2; ++k) dst[n][k] = *(const LAS bf16x8*)(lds + PG8_SB(b, h) + boff + n * 2048 + k * 1024); } while (0)
#define PG8_CAT(x) __builtin_shufflevector(__builtin_bit_cast(v4i_t, (x)[0]), __builtin_bit_cast(v4i_t, (x)[1]), 0, 1, 2, 3, 4, 5, 6, 7)
#define PG8_MMA(ai, bj, At, Bt) do { __builtin_amdgcn_s_setprio(1); _Pragma("unroll") for (int m = 0; m < 4; ++m) _Pragma("unroll") for (int n = 0; n < 2; ++n) { \
        if (F8) { const v8i_t b8_ = PG8_CAT(Bt[n]), a8_ = PG8_CAT(At[m]); asm volatile("v_mfma_scale_f32_16x16x128_f8f6f4 %0, %1, %2, %0, %3, %4 op_sel_hi:[0,0,0]" : "+v"(acc[ai][bj][m][n]) : "v"(b8_), "v"(a8_), "v"(vsw), "v"(vsx)); } \
        else { _Pragma("unroll") for (int k = 0; k < 2; ++k) acc[ai][bj][m][n] = __builtin_amdgcn_mfma_f32_16x16x32_bf16(Bt[n][k], At[m][k], acc[ai][bj][m][n], 0, 0, 0); } } __builtin_amdgcn_s_setprio(0); } while (0)
#define PG8_WAIT_V(n) asm volatile("s_waitcnt vmcnt(" #n ")" ::: "memory")
#define PG8_WAIT_L(n) asm volatile("s_waitcnt lgkmcnt(" #n ")" ::: "memory")
#define PG8_BAR __builtin_amdgcn_s_barrier()
#define PG8_SCHED __builtin_amdgcn_sched_barrier(0)
    Unit cur, nxt; int ui = 0;
    if (!S.next(0, cur)) return;
    cur.ord = 0;
    f32x4 acc[2][2][4][2];
#pragma unroll
    for (int a = 0; a < 2; ++a)
#pragma unroll
        for (int b = 0; b < 2; ++b)
#pragma unroll
            for (int m = 0; m < 4; ++m)
#pragma unroll
                for (int n = 0; n < 2; ++n) acc[a][b][m][n] = (f32x4){0.f, 0.f, 0.f, 0.f};
    bf16x8 At[4][2], B0[2][2], B1[2][2];
    typename Epi::Pre pre; (void)pre;
    const int vsw = g.sw, vsx = g.sx; (void)vsw; (void)vsx;
    const char* cA = (const char*)g.A + (size_t)cur.pm * tstepA + (size_t)((cur.pn >> g.a_shift) * g.a_goff) * 2; const char* cB = (const char*)g.Bt + (size_t)cur.pn * tstepB;
    PG8_STAGE(PG8_SB(0, 0), cB, voffB); PG8_STAGE(PG8_SB(0, 1), cB + hstepB, voffB); PG8_STAGE(PG8_SA(0, 0), cA, voffA); PG8_STAGE(PG8_SA(0, 1), cA + hstepA, voffA);
    if constexpr (Epi::NEEDS_RS) {
        LAS float* tab = (LAS float*)(lds + RS_TAB_OFF); const int row = tid >> 1, hf = tid & 1;
        for (int i0 = 0; i0 < RS_TAB_UNITS; i0 += 8) {
            Unit uu[8]; bool ok[8]; f32x4 a[8], b[8];
#pragma unroll
            for (int q = 0; q < 8; ++q) { ok[q] = S.next(i0 + q, uu[q]); const int pmq = ok[q] ? uu[q].pm : 0;
                const f32x4* p = (const f32x4*)(E.rs_src() + (size_t)(pmq * BM + row) * 16 + 8 * hf); a[q] = p[0]; b[q] = p[1]; }
#pragma unroll
            for (int q = 0; q < 8; ++q) { const f32x4 t = a[q] + b[q]; float s = (t[0] + t[1]) + (t[2] + t[3]); s += lx<1>(s);
                if (ok[q] && hf == 0) tab[(i0 + q) * 256 + row] = __builtin_amdgcn_rsqf(s * (1.f / 1024.f) + 1e-6f); }
            if (!ok[7]) break;
        }
        asm volatile("s_waitcnt vmcnt(0) lgkmcnt(0)" ::: "memory"); __builtin_amdgcn_s_barrier();
    }
    if (wr == 1) PG8_BAR;
    PG8_WAIT_V(2); PG8_BAR;
    PG8_STAGE(PG8_SB(1, 0), cB + kstep, voffB); PG8_STAGE(PG8_SA(1, 0), cA + kstep, voffA); PG8_STAGE(PG8_SB(1, 1), cB + hstepB + kstep, voffB);
    PG8_WAIT_V(6); PG8_BAR;
    for (;;) {
        const bool has_next = S.next(ui + 1, nxt);
        const char* nA = has_next ? (const char*)g.A + (size_t)nxt.pm * tstepA + (size_t)((nxt.pn >> g.a_shift) * g.a_goff) * 2 : cA; const char* nB = has_next ? (const char*)g.Bt + (size_t)nxt.pn * tstepB : cB;
#pragma unroll 1
        for (int t = 0; t < nt; t += 2) {
            const bool last = (t == nt - 2);
            const char* a1 = cA + (size_t)(t + 1) * kstep;
            const char* a2 = last ? nA : cA + (size_t)(t + 2) * kstep; const char* b2 = last ? nB : cB + (size_t)(t + 2) * kstep;
            const char* a3 = a2 + kstep; const char* b3 = b2 + kstep;
            PG8_LDB(B0, 0, 0); PG8_LDB(B1, 0, 1); PG8_SCHED; PG8_LDA(At, 0, 0); PG8_STAGE(PG8_SA(1, 1), a1 + hstepA, voffA);
            PG8_WAIT_V(8); PG8_WAIT_L(0); PG8_BAR; PG8_MMA(0, 0, At, B0); PG8_MMA(0, 1, At, B1); PG8_BAR; PG8_SCHED;
            PG8_LDA(At, 0, 1); PG8_STAGE(PG8_SB(0, 0), b2, voffB); PG8_STAGE(PG8_SB(0, 1), b2 + hstepB, voffB); PG8_STAGE(PG8_SA(0, 0), a2, voffA);
            PG8_WAIT_V(8); PG8_WAIT_L(0); PG8_BAR; PG8_MMA(1, 0, At, B0); PG8_MMA(1, 1, At, B1); PG8_BAR; PG8_SCHED;
            PG8_LDB(B0, 1, 0); PG8_LDB(B1, 1, 1); PG8_SCHED; PG8_LDA(At, 1, 0); PG8_STAGE(PG8_SA(0, 1), a2 + hstepA, voffA);
            PG8_WAIT_V(8); PG8_WAIT_L(0); PG8_BAR; PG8_MMA(0, 0, At, B0); PG8_MMA(0, 1, At, B1); PG8_BAR; PG8_SCHED;
            PG8_LDA(At, 1, 1); PG8_STAGE(PG8_SB(1, 0), b3, voffB); PG8_STAGE(PG8_SB(1, 1), b3 + hstepB, voffB); PG8_STAGE(PG8_SA(1, 0), a3, voffA);
            if constexpr (Epi::NPRE == 4) { if (last) { E.prefetch(pre, cur, wr, wc, fr, fq); PG8_WAIT_V(12); } else PG8_WAIT_V(8); }
            else PG8_WAIT_V(8);
            PG8_WAIT_L(0); PG8_BAR; PG8_MMA(1, 0, At, B0); PG8_MMA(1, 1, At, B1); PG8_BAR; PG8_SCHED;
        }
        if (wr == 0) PG8_BAR;
        if (F8) asm volatile("s_nop 15\n\ts_nop 15" ::: "memory");
        if constexpr (Epi::NPRE > 0) E(acc, cur, wr, wc, fr, fq, pre); else E(acc, cur, wr, wc, fr, fq);
        if (!has_next) break;
#pragma unroll
        for (int a = 0; a < 2; ++a)
#pragma unroll
            for (int b = 0; b < 2; ++b)
#pragma unroll
                for (int m = 0; m < 4; ++m)
#pragma unroll
                    for (int n = 0; n < 2; ++n) { f32x2 z0, z1; asm volatile("v_mov_b64 %0, 0\n\tv_mov_b64 %1, 0" : "=v"(z0), "=v"(z1)); acc[a][b][m][n] = (f32x4){z0.x, z0.y, z1.x, z1.y}; }
        cur = nxt; cA = nA; cB = nB; ++ui; cur.ord = ui;
        if (wr == 1) PG8_BAR;
    }
    PG8_WAIT_V(0);
    PG8_BAR;
#undef PG8_SA
#undef PG8_SB
#undef PG8_STAGE
#undef PG8_LDA
#undef PG8_LDB
#undef PG8_MMA
#undef PG8_CAT
#undef PG8_WAIT_V
#undef PG8_WAIT_L
#undef PG8_BAR
#undef PG8_SCHED
}

#define EPI_ARGS const f32x4 (&acc)[2][2][4][2], const Unit& u, int wr, int wc, int fr, int fq
template <int ldc> struct EpiBf16 {
    static constexpr bool PERM = true; static constexpr bool NEEDS_RS = false; static constexpr bool CMAP = false; static constexpr int NPRE = 0; struct Pre {};
    bf16_t* O;
    __device__ __forceinline__ void operator()(EPI_ARGS) const {
        asm volatile("" : "+v"(fr), "+v"(fq));
        const int row0 = u.pm * BM + wr * 64 + fr, col0 = u.pn * BM + wc * 32 + 8 * fq;
#pragma unroll
        for (int ai = 0; ai < 2; ++ai)
#pragma unroll
            for (int m = 0; m < 4; ++m) { bf16_t* rowp = O + (size_t)(row0 + ai * HALF + m * 16) * ldc + col0;
#pragma unroll
                for (int bj = 0; bj < 2; ++bj) { const f32x4 v0 = acc[ai][bj][m][0], v1 = acc[ai][bj][m][1];
                    u32x4 w; w.x = cvt_pk_bf16_v(v0[0], v0[1]); w.y = cvt_pk_bf16_v(v0[2], v0[3]); w.z = cvt_pk_bf16_v(v1[0], v1[1]); w.w = cvt_pk_bf16_v(v1[2], v1[3]);
                    *(u32x4*)(rowp + bj * HALF) = w; } }
    }
};
struct EpiSwiglu {
    static constexpr bool PERM = true; static constexpr bool NEEDS_RS = true; static constexpr bool CMAP = false; static constexpr int NPRE = 0; struct Pre {};
    unsigned char* H8; const float* sq; LAS const float* rstab;
    __device__ __forceinline__ const float* rs_src() const { return sq; }
    __device__ __forceinline__ void operator()(EPI_ARGS) const {
        asm volatile("" : "+v"(fr), "+v"(fq));
        const int row0 = u.pm * BM + wr * 64 + fr, col0 = u.pn * HALF + wc * 32 + 8 * fq;
        float rsv[8];
#pragma unroll
        for (int k = 0; k < 8; ++k) rsv[k] = rstab[u.ord * 256 + (k >> 2) * 128 + wr * 64 + (k & 3) * 16 + fr];
#pragma unroll
        for (int ai = 0; ai < 2; ++ai)
#pragma unroll
            for (int mp = 0; mp < 2; ++mp) { u32x2 w2[2];
#pragma unroll
                for (int mm = 0; mm < 2; ++mm) { const int m = 2 * mp + mm; const float rs = rsv[ai * 4 + m];
                    float h[8]; const float c1 = -rs * LOG2E, ik2 = fast_rcp(8.f * rs * rs);
#pragma unroll
                    for (int n = 0; n < 2; ++n)
#pragma unroll
                        for (int i = 0; i < 4; i += 2) { const f32x2 ag = {acc[ai][0][m][n][i], acc[ai][0][m][n][i + 1]}, au = {acc[ai][1][m][n][i], acc[ai][1][m][n][i + 1]};
                            const f32x2 t = ag * c1; f32x2 e; e.x = fast_exp2(t.x); e.y = fast_exp2(t.y); const f32x2 d = e * ik2 + ik2; f32x2 r; r.x = fast_rcp(d.x); r.y = fast_rcp(d.y);
                            const f32x2 hv = (ag * au) * r; h[4 * n + i] = hv.x; h[4 * n + i + 1] = hv.y; }
                    w2[mm].x = pk_fp8x4(h[0], h[1], h[2], h[3]); w2[mm].y = pk_fp8x4(h[4], h[5], h[6], h[7]); }
                const u32x4 w = widen16(w2[0], w2[1]);
                const int row = row0 + ai * HALF + (2 * mp + (fq & 1)) * 16;
                *(u32x4*)(H8 + (size_t)row * FF + col0 - 8 * (fq & 1)) = w; }
    }
};
__device__ __forceinline__ void unpack8(const u32x4 w, float (&f)[8]) { f[0] = bf_lo(w.x); f[1] = bf_hi(w.x); f[2] = bf_lo(w.y); f[3] = bf_hi(w.y); f[4] = bf_lo(w.z); f[5] = bf_hi(w.z); f[6] = bf_lo(w.w); f[7] = bf_hi(w.w); }
struct EpiResid {
    static constexpr bool PERM = true; static constexpr bool NEEDS_RS = false; static constexpr bool CMAP = true; static constexpr int NPRE = 0; struct Pre {};
    const bf16_t* base; bf16_t* xo; float* sq; float alpha; unsigned char* x8; LAS unsigned char* stg;
    __device__ __forceinline__ void operator()(EPI_ARGS) const {
        asm volatile("" : "+v"(fr), "+v"(fq));
        const int lane = fr + 16 * fq;
        const int row0 = u.pm * BM + wr * 64 + fr, col0 = u.pn * BM + wc * 64 + 8 * fq, colw = u.pn * BM + wc * 64;
        LAS unsigned char* sx = stg + (wr * 4 + wc) * STG_WAVE; LAS unsigned char* s8 = sx + STG_X8;
        int row0l = row0;
#pragma unroll
        for (int ai = 0; ai < 2; ++ai) {
            u32x4 old[4][2];
#pragma unroll
            for (int m = 0; m < 4; ++m)
#pragma unroll
                for (int bj = 0; bj < 2; ++bj) old[m][bj] = *(const u32x4*)(base + (size_t)(row0l + ai * HALF + m * 16) * DM + col0 + bj * 32);
            float ssm[4];
#pragma unroll
            for (int m = 0; m < 4; ++m) { const int rb = u.pm * BM + ai * HALF + wr * 64 + m * 16; float ss = 0.f;
#pragma unroll
                for (int bj = 0; bj < 2; ++bj) {
                    float b[8]; unpack8(old[m][bj], b);
                    const f32x4 a0 = acc[ai][bj][m][0], a1 = acc[ai][bj][m][1];
                    float r[8];
#pragma unroll
                    for (int i = 0; i < 4; ++i) { r[i] = b[i] + alpha * a0[i]; r[4 + i] = b[4 + i] + alpha * a1[i]; }
                    u32x4 w; w.x = cvt_pk_bf16_v(r[0], r[1]); w.y = cvt_pk_bf16_v(r[2], r[3]); w.z = cvt_pk_bf16_v(r[4], r[5]); w.w = cvt_pk_bf16_v(r[6], r[7]);
                    *(LAS u32x4*)(sx + fr * STG_PITCH + (4 * bj + fq) * 16) = w;
                    if (x8) { u32x2 z; z.x = pk_fp8x4(r[0], r[1], r[2], r[3]); z.y = pk_fp8x4(r[4], r[5], r[6], r[7]); *(LAS u32x2*)(s8 + fr * 64 + (4 * bj + fq) * 8) = z; }
                    ss += ((r[0] * r[0] + r[1] * r[1]) + (r[2] * r[2] + r[3] * r[3])) + ((r[4] * r[4] + r[5] * r[5]) + (r[6] * r[6] + r[7] * r[7])); }
                ssm[m] = x32_sum(x16_sum(ss));
                asm volatile("s_waitcnt lgkmcnt(0)" ::: "memory");
#pragma unroll
                for (int k = 0; k < 2; ++k) { const int r = 8 * k + (lane >> 3), c = lane & 7; const u32x4 v = *(LAS const u32x4*)(sx + r * STG_PITCH + c * 16); *(u32x4*)(xo + (size_t)(rb + r) * DM + colw + c * 8) = v; }
                if (x8) { const int r = lane >> 2, c = lane & 3; const u32x4 v = *(LAS const u32x4*)(s8 + r * 64 + c * 16); *(u32x4*)(x8 + (size_t)(rb + r) * DM + colw + c * 16) = v; }
            }
            { const float sel = (fq == 0) ? ssm[0] : (fq == 1) ? ssm[1] : (fq == 2) ? ssm[2] : ssm[3];
              sq[(size_t)(row0 + ai * HALF + fq * 16) * 16 + u.pn * 4 + wc] = sel; }
            asm volatile("" : "+v"(row0l) :: "memory");
        }
    }
};
struct EpiPle {
    static constexpr bool PERM = true; static constexpr bool NEEDS_RS = true; static constexpr bool CMAP = true; static constexpr int NPRE = 0; struct Pre {};
    const bf16_t* xi; bf16_t* xo; const bf16_t* Eb; const float* sq_in; float* sq_out; unsigned char* x8; LAS const float* rstab; LAS unsigned char* stg;
    __device__ __forceinline__ const float* rs_src() const { return sq_in; }
    __device__ __forceinline__ void operator()(EPI_ARGS) const {
        asm volatile("" : "+v"(fr), "+v"(fq));
        const int lane = fr + 16 * fq;
        const int row0 = u.pm * BM + wr * 64 + fr, col0 = u.pn * BM + wc * 64 + 8 * fq, colw = u.pn * BM + wc * 64;
        LAS unsigned char* sx = stg + (wr * 4 + wc) * STG_WAVE; LAS unsigned char* s8 = sx + STG_X8;
        float rsv[8];
#pragma unroll
        for (int k = 0; k < 8; ++k) rsv[k] = rstab[u.ord * 256 + (k >> 2) * 128 + wr * 64 + (k & 3) * 16 + fr];
        int row0l = row0; asm volatile("" : "+v"(row0l) : "v"(rsv[7]));
#pragma unroll
        for (int hq = 0; hq < 4; ++hq) {
            const int ai = hq >> 1;
            u32x4 ox[2][2], oe[2][2];
#pragma unroll
            for (int mm = 0; mm < 2; ++mm)
#pragma unroll
                for (int bj = 0; bj < 2; ++bj) { const size_t off = (size_t)(row0l + ai * HALF + (2 * (hq & 1) + mm) * 16) * DM + col0 + bj * 32; ox[mm][bj] = *(const u32x4*)(xi + off); oe[mm][bj] = *(const u32x4*)(Eb + off); }
            float ssm[2];
#pragma unroll
            for (int mm = 0; mm < 2; ++mm) { const int m = 2 * (hq & 1) + mm; const int rb = u.pm * BM + ai * HALF + wr * 64 + m * 16; float ss = 0.f; const float rs = rsv[ai * 4 + m];
#pragma unroll
                for (int bj = 0; bj < 2; ++bj) {
                    float b[8], e[8]; unpack8(ox[mm][bj], b); unpack8(oe[mm][bj], e);
                    const f32x4 a0 = acc[ai][bj][m][0], a1 = acc[ai][bj][m][1]; const float c1 = -rs * LOG2E;
                    const f32x2 g0 = sig2_t((f32x2){a0[0], a0[1]} * c1), g1 = sig2_t((f32x2){a0[2], a0[3]} * c1), g2 = sig2_t((f32x2){a1[0], a1[1]} * c1), g3 = sig2_t((f32x2){a1[2], a1[3]} * c1);
                    const f32x2 y0 = (f32x2){b[0], b[1]} + g0 * (f32x2){e[0], e[1]}, y1 = (f32x2){b[2], b[3]} + g1 * (f32x2){e[2], e[3]}, y2 = (f32x2){b[4], b[5]} + g2 * (f32x2){e[4], e[5]}, y3 = (f32x2){b[6], b[7]} + g3 * (f32x2){e[6], e[7]};
                    u32x4 w; w.x = cvt_pk_bf16_v(y0.x, y0.y); w.y = cvt_pk_bf16_v(y1.x, y1.y); w.z = cvt_pk_bf16_v(y2.x, y2.y); w.w = cvt_pk_bf16_v(y3.x, y3.y);
                    *(LAS u32x4*)(sx + fr * STG_PITCH + (4 * bj + fq) * 16) = w; const float r[8] = {y0.x, y0.y, y1.x, y1.y, y2.x, y2.y, y3.x, y3.y};
                    { u32x2 z; z.x = pk_fp8x4(r[0], r[1], r[2], r[3]); z.y = pk_fp8x4(r[4], r[5], r[6], r[7]); *(LAS u32x2*)(s8 + fr * 64 + (4 * bj + fq) * 8) = z; }
                    ss += ((r[0] * r[0] + r[1] * r[1]) + (r[2] * r[2] + r[3] * r[3])) + ((r[4] * r[4] + r[5] * r[5]) + (r[6] * r[6] + r[7] * r[7])); }
                ssm[mm] = x32_sum(x16_sum(ss));
                asm volatile("s_waitcnt lgkmcnt(0)" ::: "memory");
#pragma unroll
                for (int k = 0; k < 2; ++k) { const int r = 8 * k + (lane >> 3), c = lane & 7; const u32x4 v = *(LAS const u32x4*)(sx + r * STG_PITCH + c * 16); *(u32x4*)(xo + (size_t)(rb + r) * DM + colw + c * 8) = v; }
                { const int r = lane >> 2, c = lane & 3; const u32x4 v = *(LAS const u32x4*)(s8 + r * 64 + c * 16); *(u32x4*)(x8 + (size_t)(rb + r) * DM + colw + c * 16) = v; }
            }
            if (fq < 2) sq_out[(size_t)(row0 + ai * HALF + (2 * (hq & 1) + fq) * 16) * 16 + u.pn * 4 + wc] = (fq == 0) ? ssm[0] : ssm[1];
            asm volatile("" : "+v"(row0l) :: "memory");
        }
    }
};
struct EpiPnat {
    static constexpr bool PERM = false; static constexpr bool NEEDS_RS = false; static constexpr bool CMAP = false; static constexpr int NPRE = 0; struct Pre {};
    unsigned* Pn;
    __device__ __forceinline__ void operator()(EPI_ARGS) const {
        asm volatile("" : "+v"(fr), "+v"(fq));
        const int nb = u.pn >> 2, lane = fr + 16 * fq;
#pragma unroll
        for (int ai = 0; ai < 2; ++ai)
#pragma unroll
            for (int bj = 0; bj < 2; ++bj)
#pragma unroll
                for (int n = 0; n < 2; ++n) { const int png = 4 * (u.pn & 3) + 2 * bj + (wc >> 1), wcg = 2 * (wc & 1) + n; u32x4 o;
#pragma unroll
                    for (int m = 0; m < 4; ++m) { const f32x4 a = acc[ai][bj][m][n] * 4.f; o[m] = pk_fp8x4(a[0], a[1], a[2], a[3]); }
                    *(u32x4*)(Pn + ((((((size_t)u.pm * 16 + png) * 8 + wr * 4 + wcg) * 2 + ai) * 4 + nb) * 64 + lane) * 4) = o; }
    }
};
struct EpiGate {
    static constexpr bool PERM = false; static constexpr bool NEEDS_RS = true; static constexpr bool CMAP = false; static constexpr int NPRE = 4; struct Pre { u32x4 p[4]; };
    unsigned char* MB; const unsigned* Pn; const float* sq; LAS const float* rstab;
    __device__ __forceinline__ const float* rs_src() const { return sq; }
    __device__ __forceinline__ void prefetch(Pre& pre, const Unit& u, int wr, int wc, int fr, int fq) const {
        const int lane = fr + 16 * fq;
#pragma unroll
        for (int nb = 0; nb < 4; ++nb) pre.p[nb] = *(const u32x4*)(Pn + ((((((size_t)u.pm * 16 + u.pn) * 8 + wr * 4 + wc) * 2 + 0) * 4 + nb) * 64 + lane) * 4);
    }
    __device__ __forceinline__ void operator()(EPI_ARGS, const Pre& pre) const {
        asm volatile("" : "+v"(fr), "+v"(fq));
        const int row0 = u.pm * BM + wr * 64 + fr, col0 = u.pn * 64 + wc * 16 + 4 * fq, lane = fr + 16 * fq;
        float rsv[8];
#pragma unroll
        for (int k = 0; k < 8; ++k) rsv[k] = rstab[u.ord * 256 + (k >> 2) * 128 + wr * 64 + (k & 3) * 16 + fr];
        u32x4 p1v[4];
#pragma unroll
        for (int nb = 0; nb < 4; ++nb) p1v[nb] = *(const u32x4*)(Pn + ((((((size_t)u.pm * 16 + u.pn) * 8 + wr * 4 + wc) * 2 + 1) * 4 + nb) * 64 + lane) * 4);
#pragma unroll
        for (int ai = 0; ai < 2; ++ai) {
            unsigned pv[4][4];
#pragma unroll
            for (int nb = 0; nb < 4; ++nb) { const u32x4 t = (ai == 0) ? pre.p[nb] : p1v[nb];
#pragma unroll
                for (int m = 0; m < 4; ++m) pv[m][nb] = t[m]; }
            unsigned wm[4];
#pragma unroll
            for (int m = 0; m < 4; ++m) { const float rs = rsv[ai * 4 + m];
                f32x2 s01 = {0.f, 0.f}, s23 = {0.f, 0.f}; const float c1 = -rs * LOG2E;
#pragma unroll
                for (int bj = 0; bj < 2; ++bj)
#pragma unroll
                    for (int n = 0; n < 2; ++n) { const int p4 = (int)pv[m][2 * bj + n]; const f32x4 a = acc[ai][bj][m][n];
                        const f32x2 r0 = sig2_t((f32x2){a[0], a[1]} * c1), r1 = sig2_t((f32x2){a[2], a[3]} * c1);
                        const f32x2 q0 = __builtin_amdgcn_cvt_pk_f32_fp8(p4, false), q1 = __builtin_amdgcn_cvt_pk_f32_fp8(p4, true);
                        s01 += r0 * q0; s23 += r1 * q1; }
                wm[m] = pk_fp8x4(s01.x * 2.f, s01.y * 2.f, s23.x * 2.f, s23.y * 2.f); }
            { auto a = __builtin_amdgcn_permlane16_swap(wm[0], wm[1], false, false); wm[0] = a[0]; wm[1] = a[1]; auto b = __builtin_amdgcn_permlane16_swap(wm[2], wm[3], false, false); wm[2] = b[0]; wm[3] = b[1];
              auto c = __builtin_amdgcn_permlane32_swap(wm[0], wm[2], false, false); wm[0] = c[0]; wm[2] = c[1]; auto d = __builtin_amdgcn_permlane32_swap(wm[1], wm[3], false, false); wm[1] = d[0]; wm[3] = d[1]; }
            *(u32x4*)(MB + (size_t)(row0 + ai * HALF + fq * 16) * DM + u.pn * 64 + wc * 16) = (u32x4){wm[0], wm[1], wm[2], wm[3]};
        }
    }
};
struct EpiMix {
    static constexpr bool PERM = true; static constexpr bool NEEDS_RS = true; static constexpr bool CMAP = false; static constexpr int NPRE = 0; struct Pre {};
    bf16_t* MIX; const float* sq; float* sqq; float* sqkv; bf16_t* KR; float* LF; const float* ropec; const float* ropes; const float* bf; float* K2P; LAS const float* rstab;
    __device__ __forceinline__ const float* rs_src() const { return sq; }
    __device__ __forceinline__ void operator()(EPI_ARGS) const {
        asm volatile("" : "+v"(fr), "+v"(fq));
        const int row0 = u.pm * BM + wr * 64 + fr, col0 = u.pn * BM + wc * 32 + 8 * fq;
        const bool special = (u.pn == 1) || (u.pn == 3) || (u.pn == 4);
        float rsv[8];
#pragma unroll
        for (int k = 0; k < 8; ++k) rsv[k] = rstab[u.ord * 256 + (k >> 2) * 128 + wr * 64 + (k & 3) * 16 + fr];
#pragma unroll
        for (int ai = 0; ai < 2; ++ai)
#pragma unroll
            for (int m = 0; m < 4; ++m) { const int row = row0 + ai * HALF + m * 16; const float rs = rsv[ai * 4 + m];
                u32x4 w[2];
#pragma unroll
                for (int bj = 0; bj < 2; ++bj) { const f32x4 a0 = acc[ai][bj][m][0] * rs, a1 = acc[ai][bj][m][1] * rs;
                    w[bj].x = cvt_pk_bf16_v(a0[0], a0[1]); w[bj].y = cvt_pk_bf16_v(a0[2], a0[3]); w[bj].z = cvt_pk_bf16_v(a1[0], a1[1]); w[bj].w = cvt_pk_bf16_v(a1[2], a1[3]);
                    *(u32x4*)(MIX + (size_t)row * NMIX + col0 + bj * HALF) = w[bj]; }
                if (special) {
                    float q2[2];
#pragma unroll
                    for (int bj = 0; bj < 2; ++bj) { float r[8]; unpack8(w[bj], r); float q = ((r[0] * r[0] + r[1] * r[1]) + (r[2] * r[2] + r[3] * r[3])) + ((r[4] * r[4] + r[5] * r[5]) + (r[6] * r[6] + r[7] * r[7]));
                        q2[bj] = x32_sum(x16_sum(q)); }
                    if (u.pn == 1) { if (fq == 0) { K2P[(size_t)row * 8 + (wc >> 1) * 2 + (wc & 1)] = q2[0]; K2P[(size_t)row * 8 + (2 + (wc >> 1)) * 2 + (wc & 1)] = q2[1]; } }
                    if (u.pn == 3) { if (fq == 0) sqq[(size_t)row * 4 + wc] = q2[0] + q2[1]; }
                    if (u.pn == 4) { if (fq == 0) sqkv[(size_t)row * 4 + wc] = q2[0];
                        if (wc == 0) {
                            const int pos = row & (SEQ - 1); const f32x4 c = *(const f32x4*)(ropec + pos * 16 + 4 * fq), s = *(const f32x4*)(ropes + pos * 16 + 4 * fq);
                            const f32x4 x1 = acc[ai][1][m][0] * rs, x2 = acc[ai][1][m][1] * rs; const f32x4 o1 = x1 * c - x2 * s, o2 = x2 * c + x1 * s;
                            u32x2 w1, w2; w1.x = cvt_pk_bf16_v(o1[0], o1[1]); w1.y = cvt_pk_bf16_v(o1[2], o1[3]); w2.x = cvt_pk_bf16_v(o2[0], o2[1]); w2.y = cvt_pk_bf16_v(o2[2], o2[3]);
                            *(u32x2*)(KR + (size_t)row * 32 + 4 * fq) = w1; *(u32x2*)(KR + (size_t)row * 32 + 16 + 4 * fq) = w2; }
                        if (wc == 1 && fq == 0) {
                            const f32x4 vv = acc[ai][1][m][0] * rs; f32x4 o;
#pragma unroll
                            for (int i = 0; i < 4; ++i) { const float z = vv[i] + bf[i]; o[i] = -(fmaxf(-z, 0.f) + LN2 * fast_log2(1.f + fast_exp2(-fabsf(z) * LOG2E))); }
                            *(f32x4*)(LF + (size_t)row * 4) = o; } }
                }
            }
    }
};
struct EpiQup {
    static constexpr bool PERM = true; static constexpr bool NEEDS_RS = false; static constexpr bool CMAP = false; static constexpr int NPRE = 0; struct Pre {};
    bf16_t* QM; const float* sqq; const float* ropec; const float* ropes;
    __device__ __forceinline__ void operator()(EPI_ARGS) const {
        asm volatile("" : "+v"(fr), "+v"(fq));
        const int row0 = u.pm * BM + wr * 64 + fr;
        float rsv[8]; rstd4_rows(sqq, row0, 1.f / 256.f, rsv);
#pragma unroll
        for (int ai = 0; ai < 2; ++ai)
#pragma unroll
            for (int m = 0; m < 4; ++m) { const int row = row0 + ai * HALF + m * 16; const float rs = rsv[ai * 4 + m]; bf16_t* qrow = QM + (size_t)row * 384;
                if (u.pn == 0) {
#pragma unroll
                    for (int bj = 0; bj < 2; ++bj) { const f32x4 a0 = acc[ai][bj][m][0] * rs, a1 = acc[ai][bj][m][1] * rs; const int head = 2 * bj + (wc >> 1), d = 32 * (wc & 1) + 8 * fq;
                        u32x4 w; w.x = cvt_pk_bf16_v(a0[0], a0[1]); w.y = cvt_pk_bf16_v(a0[2], a0[3]); w.z = cvt_pk_bf16_v(a1[0], a1[1]); w.w = cvt_pk_bf16_v(a1[2], a1[3]); *(u32x4*)(qrow + 96 * head + d) = w; }
                } else {
                    const int pos = row & (SEQ - 1); const f32x4 c = *(const f32x4*)(ropec + pos * 16 + 4 * fq), s = *(const f32x4*)(ropes + pos * 16 + 4 * fq);
                    const f32x4 x1 = acc[ai][0][m][0] * rs, x2 = acc[ai][0][m][1] * rs; const f32x4 o1 = x1 * c - x2 * s, o2 = x2 * c + x1 * s;
                    u32x2 w1, w2; w1.x = cvt_pk_bf16_v(o1[0], o1[1]); w1.y = cvt_pk_bf16_v(o1[2], o1[3]); w2.x = cvt_pk_bf16_v(o2[0], o2[1]); w2.y = cvt_pk_bf16_v(o2[2], o2[3]);
                    *(u32x2*)(qrow + 96 * wc + 64 + 4 * fq) = w1; *(u32x2*)(qrow + 96 * wc + 80 + 4 * fq) = w2; }
                asm volatile("" ::: "memory");
            }
    }
};
struct EpiKVup {
    static constexpr bool PERM = true; static constexpr bool NEEDS_RS = false; static constexpr bool CMAP = false; static constexpr int NPRE = 0; struct Pre {};
    bf16_t* KN; bf16_t* VM; const float* sqkv;
    __device__ __forceinline__ void operator()(EPI_ARGS) const {
        asm volatile("" : "+v"(fr), "+v"(fq));
        const int row0 = u.pm * BM + wr * 64 + fr;
        float rsv[8]; rstd4_rows(sqkv, row0, 1.f / 128.f, rsv);
#pragma unroll
        for (int ai = 0; ai < 2; ++ai)
#pragma unroll
            for (int m = 0; m < 4; ++m) { const int row = row0 + ai * HALF + m * 16; const float rs = rsv[ai * 4 + m];
#pragma unroll
                for (int bj = 0; bj < 2; ++bj) { const f32x4 a0 = acc[ai][bj][m][0] * rs, a1 = acc[ai][bj][m][1] * rs; const int head = 2 * u.pn + bj, col = 32 * (wc & 1) + 8 * fq;
                    u32x4 w; w.x = cvt_pk_bf16_v(a0[0], a0[1]); w.y = cvt_pk_bf16_v(a0[2], a0[3]); w.z = cvt_pk_bf16_v(a1[0], a1[1]); w.w = cvt_pk_bf16_v(a1[2], a1[3]);
                    bf16_t* dst = (wc < 2 ? KN : VM) + (size_t)row * 256 + 64 * head + col; *(u32x4*)dst = w; }
                asm volatile("" ::: "memory");
            }
    }
};
struct EpiQKVup {
    static constexpr bool PERM = true; static constexpr bool NEEDS_RS = false; static constexpr bool CMAP = false; static constexpr int NPRE = 0; struct Pre {};
    EpiQup q; EpiKVup kv;
    __device__ __forceinline__ void operator()(EPI_ARGS) const {
        if (u.pn < 2) q(acc, u, wr, wc, fr, fq); else { Unit u2 = u; u2.pn = u.pn - 2; kv(acc, u2, wr, wc, fr, fq); }
    }
};
}

constexpr size_t MiB = 1u << 20;
constexpr size_t WS_CTL = 0, CTL_ZERO_BYTES = 1 * MiB;
constexpr size_t WS_SQ = 1 * MiB;
constexpr size_t WS_ROPE = 19 * MiB;
constexpr size_t WS_LF = 20 * MiB;
constexpr size_t WS_KX = 21 * MiB;
constexpr size_t WS_TB = 25 * MiB;
constexpr size_t WS_K2P = 26 * MiB;
constexpr size_t WS_HGS = 28 * MiB;
constexpr size_t WS_W = 45 * MiB;
constexpr size_t WS_PB = 101 * MiB;
constexpr size_t WS_XB = 133 * MiB;
constexpr size_t WS_YS = 261 * MiB;
constexpr size_t WS_BIG = 389 * MiB;
constexpr size_t WS_X8 = 901 * MiB, WS_END = 965 * MiB;
constexpr size_t BIG_MIX = 0, BIG_QM = 384 * MiB, BIG_KN = 432 * MiB, BIG_VM = 464 * MiB, BIG_KR = 496 * MiB;
constexpr size_t WO_FA1 = 0, WO_FA2 = WO_FA1 + (size_t)5632 * 1024, WO_FB1 = WO_FA2 + (size_t)1024 * 2816, WO_FB2 = WO_FB1 + (size_t)5632 * 1024, WO_MIX = WO_FB2 + (size_t)1024 * 2816,
    WO_GATE = WO_MIX + (size_t)3072 * 1024, WO_UQ = WO_GATE + (size_t)4096 * 1024, WO_UKV = WO_UQ + (size_t)512 * 256, WO_BR = WO_UKV + (size_t)512 * 256, WO_OUT = WO_BR + (size_t)4096 * 256,
    WO_PG = WO_OUT + (size_t)1024 * 1024, WO_PE = WO_PG + (size_t)1024 * 1024, WO_END = WO_PE + (size_t)1024 * 256;
static_assert(WO_END * 2 <= 56 * MiB, "weight copies fit");
constexpr int CW_BAR = 4096;

constexpr int RING_BYTES = 131072, LDSCTL_OFF = RING_BYTES, MISC_OFF = LDSCTL_OFF + 320, LDS_BYTES = 163840;
static_assert(pg8::RS_TAB_OFF >= MISC_OFF + 256 && pg8::RS_TAB_OFF + pg8::RS_TAB_UNITS * 1024 <= LDS_BYTES && pg8::STG_OFF + 8 * pg8::STG_WAVE <= LDS_BYTES, "LDS map");
constexpr int NWAVES = 8;

#define RLX_AGENT __ATOMIC_RELAXED, __HIP_MEMORY_SCOPE_AGENT
#define LDS_WAIT() asm volatile("s_waitcnt lgkmcnt(0)" ::: "memory")
#define VM_WAIT() asm volatile("s_waitcnt vmcnt(0)" ::: "memory")

#define XB_TMO      128
#define XB_XCNT(j)  (256  + 64 * (j))
#define XB_XSUB(j)  (1280 + 64 * (j))
#define XB_XGEN(j)  (2304 + 64 * (j))
#define XB_TOP      3328
#define XB_TOPGEN   3392
#define XCD_BAR_WORDS 3456
#define XB_SPIN_CAP (1u << 20)
__device__ __forceinline__ unsigned xb_ld(unsigned* p)              { return __hip_atomic_load(p, __ATOMIC_RELAXED, __HIP_MEMORY_SCOPE_AGENT); }
__device__ __forceinline__ unsigned xb_add(unsigned* p, unsigned v) { return __hip_atomic_fetch_add(p, v, __ATOMIC_RELAXED, __HIP_MEMORY_SCOPE_AGENT); }
__device__ __forceinline__ unsigned xb_xcc_id() { return (unsigned)__builtin_amdgcn_s_getreg((3 << 11) | 20) & 0xFu; }
#define XB_SPIN(cond, bar) do { unsigned _sp = 0; while (cond) { __builtin_amdgcn_s_sleep(1); \
    if ((++_sp & 255u) == 0u) { if (xb_ld(&(bar)[XB_TMO])) break; if (_sp > XB_SPIN_CAP) { atomicAdd(&(bar)[XB_TMO], 1u); break; } } } } while (0)
struct XcdBarrier { unsigned* bar; unsigned x; volatile LAS unsigned* st; };
__device__ __forceinline__ XcdBarrier xcd_barrier_post(unsigned* bar, volatile LAS unsigned* st, const bool leader) {
    XcdBarrier b; b.bar = bar; b.x = xb_xcc_id(); b.st = st;
    if (leader) (void)xb_add(&bar[XB_XCNT(b.x)], 1u);
    return b;
}
__device__ __forceinline__ void xcd_barrier_complete(unsigned* bar, unsigned x, unsigned& nloc, unsigned& nx) {
    const unsigned G = gridDim.x * gridDim.y * gridDim.z;
    unsigned sum, cnt, mine, sp = 0u;
    for (;;) {
        sum = 0u; cnt = 0u; mine = 0u;
#pragma unroll
        for (unsigned j = 0; j < 16; ++j) { const unsigned c = xb_ld(&bar[XB_XCNT(j)]); sum += c; cnt += (c > 0u) ? 1u : 0u; mine = (j == x) ? c : mine; }
        if (sum == G) break;
        __builtin_amdgcn_s_sleep(1);
        if ((++sp & 255u) == 0u) { if (xb_ld(&bar[XB_TMO])) break; if (sp > XB_SPIN_CAP) { atomicAdd(&bar[XB_TMO], 1u); break; } }
    }
    nloc = mine > 0u ? mine : 1u; nx = cnt > 0u ? cnt : 1u;
}
__device__ __forceinline__ void xcd_barrier(const XcdBarrier& b, const bool leader) {
    asm volatile("s_waitcnt vmcnt(0)" ::: "memory");
    __syncthreads();
    if (leader) {
        unsigned* bar = b.bar;
        __builtin_amdgcn_s_waitcnt(0);
        unsigned nloc = b.st[0], nx = b.st[1];
        if (nloc == 0u) { xcd_barrier_complete(bar, b.x, nloc, nx); b.st[0] = nloc; b.st[1] = nx; }
        const unsigned old = xb_add(&bar[XB_XSUB(b.x)], 1u);
        const unsigned gen = old / nloc;
        if (old + 1u == (gen + 1u) * nloc) {
            __builtin_amdgcn_fence(__ATOMIC_RELEASE, "agent");
            asm volatile("s_waitcnt vmcnt(0)" ::: "memory");
            const unsigned og = xb_add(&bar[XB_TOP], 1u);
            const unsigned tg = og / nx;
            if (og + 1u == (tg + 1u) * nx) xb_add(&bar[XB_TOPGEN], 1u);
            else XB_SPIN(xb_ld(&bar[XB_TOPGEN]) == tg, bar);
            __builtin_amdgcn_fence(__ATOMIC_ACQUIRE, "agent");
            xb_add(&bar[XB_XGEN(b.x)], 1u);
            asm volatile("s_waitcnt vmcnt(0)" ::: "memory");
        } else {
            XB_SPIN(xb_ld(&bar[XB_XGEN(b.x)]) == gen, bar);
            __builtin_amdgcn_fence(__ATOMIC_ACQUIRE, "agent");
            asm volatile("s_waitcnt vmcnt(0)" ::: "memory");
        }
    }
    __syncthreads();
}

__device__ __forceinline__ void xcd_barrier_local(const XcdBarrier& b, const bool leader) {
    asm volatile("s_waitcnt vmcnt(0)" ::: "memory");
    __syncthreads();
    if (leader) {
        unsigned* bar = b.bar;
        __builtin_amdgcn_s_waitcnt(0);
        unsigned nloc = b.st[0], nx = b.st[1];
        if (nloc == 0u) { xcd_barrier_complete(bar, b.x, nloc, nx); b.st[0] = nloc; b.st[1] = nx; }
        const unsigned old = xb_add(&bar[XB_XSUB(b.x)], 1u);
        const unsigned gen = old / nloc;
        if (old + 1u == (gen + 1u) * nloc) (void)xb_add(&bar[XB_XGEN(b.x)], 1u);
        else XB_SPIN(xb_ld(&bar[XB_XGEN(b.x)]) == gen, bar);
        __builtin_amdgcn_fence(__ATOMIC_ACQUIRE, "agent");
        asm volatile("s_waitcnt vmcnt(0)" ::: "memory");
    }
    __syncthreads();
}

enum { MK_ID = 0, MK_FFN1 = 1, MK_MIX = 2, MK_GATE = 3, MK_UQ = 4 };
__device__ __forceinline__ int srcmap(int kind, int v, float& sc) {
    sc = 1.f;
    if (kind == MK_ID) return v;
    if (kind == MK_FFN1) { const int pn = v >> 8, r = v & 255; return r < 128 ? 128 * pn + r : FF + 128 * pn + (r - 128); }
    if (kind == MK_GATE) { const int pn = v >> 8, r = v & 255, bj = r >> 7, wc = (r >> 5) & 3, n = (r >> 4) & 1, jj = r & 15; return 2980 + 1024 * (2 * bj + n) + 64 * pn + 16 * wc + jj; }
    if (kind == MK_UQ) { sc = 0.10206207261596577f * LOG2E; if (v < 256) return 96 * (v >> 6) + (v & 63); if (v < 384) { const int w = v - 256, rr = w & 31; return 96 * (w >> 5) + 64 + 16 * ((rr >> 2) & 1) + 4 * (rr >> 3) + (rr & 3); } return -1; }
    const int t = v >> 8, r = v & 255;
    switch (t) {
        case 0: sc = 0.125f * LOG2E; return r;
        case 1: return 256 + r;
        case 2: return 512 + r;
        case 3: return 772 + r;
        case 4: if (r < 128) return 1028 + r; if (r < 160) { const int rr = r - 128; return 1156 + 16 * ((rr >> 2) & 1) + 4 * (rr >> 3) + (rr & 3); } if (r < 164) return 768 + (r - 160); return -1;
        case 5: sc = 0.125f * LOG2E; return 1188 + r;
        case 6: return 1444 + r;
        case 7: return 1700 + r;
        case 8: return 1956 + r;
        case 9: return 2212 + r;
        case 10: return 2468 + r;
        default: return 2724 + r;
    }
}
__device__ __forceinline__ void conv_item(const float* __restrict__ W, int ldw, int Ksrc, int K, const float* __restrict__ gain, bf16_t* WT, int kind, LAS float* scr, int it, int nblk, int lane) {
    const int kb = it / nblk, nb = it % nblk, k0 = 64 * kb, n0 = 32 * nb;
    float sc; const int c = srcmap(kind, n0 + (lane & 31), sc);
    float gl = 1.f; if (gain && k0 + lane < Ksrc) gl = gain[k0 + lane];
    float v[32];
#pragma unroll
    for (int i = 0; i < 32; ++i) { const int k = k0 + 2 * i + (lane >> 5); v[i] = (c >= 0 && k < Ksrc) ? W[(size_t)k * ldw + c] : 0.f; }
#pragma unroll
    for (int i = 0; i < 32; ++i) { const int kk = 2 * i + (lane >> 5);
        const float g0 = __uint_as_float((unsigned)__builtin_amdgcn_readlane((int)__float_as_uint(gl), 2 * i)), g1 = __uint_as_float((unsigned)__builtin_amdgcn_readlane((int)__float_as_uint(gl), 2 * i + 1));
        scr[kk * 33 + (lane & 31)] = v[i] * sc * ((lane >> 5) ? g1 : g0); }
    LDS_WAIT(); asm volatile("" ::: "memory");
    const int ch = lane & 7;
#pragma unroll
    for (int j = 0; j < 4; ++j) { const int n = (lane >> 3) + 8 * j; const LAS float* s = scr + (8 * ch) * 33 + n;
        u32x4 o; o.x = cvt_pk_bf16(s[0 * 33], s[1 * 33]); o.y = cvt_pk_bf16(s[2 * 33], s[3 * 33]); o.z = cvt_pk_bf16(s[4 * 33], s[5 * 33]); o.w = cvt_pk_bf16(s[6 * 33], s[7 * 33]);
        *(u32x4*)(WT + (size_t)(n0 + n) * K + k0 + 8 * ch) = o; }
    LDS_WAIT(); asm volatile("" ::: "memory");
}
__device__ __forceinline__ void conv_item8(const float* __restrict__ W, int ldw, int K, const float* __restrict__ gain, unsigned char* WT8, int kind, LAS float* scr, int it, int nblk, int lane, float qs) {
    const int kb = it / nblk, nb = it % nblk, k0 = 64 * kb, n0 = 32 * nb;
    float sc; const int c = srcmap(kind, n0 + (lane & 31), sc); sc *= qs;
    float gl = 1.f; if (gain) gl = gain[k0 + lane];
    float v[32];
#pragma unroll
    for (int i = 0; i < 32; ++i) { const int k = k0 + 2 * i + (lane >> 5); v[i] = (c >= 0) ? W[(size_t)k * ldw + c] : 0.f; }
#pragma unroll
    for (int i = 0; i < 32; ++i) { const int kk = 2 * i + (lane >> 5);
        const float g0 = __uint_as_float((unsigned)__builtin_amdgcn_readlane((int)__float_as_uint(gl), 2 * i)), g1 = __uint_as_float((unsigned)__builtin_amdgcn_readlane((int)__float_as_uint(gl), 2 * i + 1));
        scr[kk * 33 + (lane & 31)] = v[i] * sc * ((lane >> 5) ? g1 : g0); }
    LDS_WAIT(); asm volatile("" ::: "memory");
    const int ch = lane & 3;
#pragma unroll
    for (int j = 0; j < 2; ++j) { const int n = (lane >> 2) + 16 * j; const LAS float* s = scr + (16 * ch) * 33 + n;
        u32x4 o; o.x = pk_fp8x4(s[0 * 33], s[1 * 33], s[2 * 33], s[3 * 33]); o.y = pk_fp8x4(s[4 * 33], s[5 * 33], s[6 * 33], s[7 * 33]);
        o.z = pk_fp8x4(s[8 * 33], s[9 * 33], s[10 * 33], s[11 * 33]); o.w = pk_fp8x4(s[12 * 33], s[13 * 33], s[14 * 33], s[15 * 33]);
        *(u32x4*)(WT8 + (size_t)(n0 + n) * K + k0 + 16 * ch) = o; }
    LDS_WAIT(); asm volatile("" ::: "memory");
}
struct ConvCtx { LAS float* scr; int gw, NGW, lane, base; };
__device__ __forceinline__ void conv_mat(ConvCtx& C, const float* W, int ldw, int Ksrc, int K, int Nv, const float* gain, bf16_t* WT, int kind) {
    const int nblk = Nv / 32, n = (K / 64) * nblk;
    int it = C.gw - (C.base % C.NGW); if (it < 0) it += C.NGW;
    for (; it < n; it += C.NGW) conv_item(W, ldw, Ksrc, K, gain, WT, kind, C.scr, it, nblk, C.lane);
    C.base += n;
}
__device__ __forceinline__ void conv_mat8(ConvCtx& C, const float* W, int ldw, int K, int Nv, const float* gain, unsigned char* WT8, int kind, float qs) {
    const int nblk = Nv / 32, n = (K / 64) * nblk;
    int it = C.gw - (C.base % C.NGW); if (it < 0) it += C.NGW;
    for (; it < n; it += C.NGW) conv_item8(W, ldw, K, gain, WT8, kind, C.scr, it, nblk, C.lane, qs);
    C.base += n;
}

namespace att {
constexpr int KSLOT = 12288, VSLOT = 8192;
constexpr int LDS_K = 0, LDS_V = 3 * KSLOT, LDS_WS = LDS_V + 2 * VSLOT, LDS_OST = LDS_WS + 8 * 256, LDS_FLAG = LDS_OST + 8 * 4096, LDS_TB = LDS_FLAG + 64, LDS_BYTES = LDS_TB + 1024;
static_assert(LDS_BYTES <= RING_BYTES, "attention scratch fits the ring region");
enum { FOX = 0, MLA = 1, SB = 2 };
struct Args { const bf16_t* Q; int ldq, hqs; const bf16_t* K; int ldk; const bf16_t* K2; const bf16_t* V; int ldv; const float* TB; const float* KMX; bf16_t* O; };
__device__ __forceinline__ int crow(int r, int hi) { return (r & 3) + 8 * (r >> 2) + 4 * hi; }
__device__ __forceinline__ void glds16(const void* gsrc, unsigned lds_dst) { unsigned keep;
    asm volatile("s_mov_b32 %0, m0\n\ts_mov_b32 m0, %2\n\ts_nop 0\n\tglobal_load_lds_dwordx4 %1, off\n\ts_mov_b32 m0, %0" : "=&s"(keep) : "v"(gsrc), "s"(lds_dst) : "memory"); }
#define ATT_MFMA(a, b, c) __builtin_amdgcn_mfma_f32_32x32x16_bf16(a, b, c, 0, 0, 0)
__device__ __forceinline__ void pv(f32x16* o, int vb, bf16x8 pa0, bf16x8 pa1, bf16x8 pa2, bf16x8 pa3) {
    s16x4 lo[2][4], hi[2][4];
#pragma unroll
    for (int d0 = 0; d0 < 2; ++d0)
#pragma unroll
        for (int ks = 0; ks < 4; ++ks) {
            asm volatile("ds_read_b64_tr_b16 %0,%1 offset:%c2" : "=&v"(lo[d0][ks]) : "v"(vb), "i"(d0 * 4096 + ks * 1024) : "memory");
            asm volatile("ds_read_b64_tr_b16 %0,%1 offset:%c2" : "=&v"(hi[d0][ks]) : "v"(vb), "i"(d0 * 4096 + ks * 1024 + 512) : "memory"); }
#define ATT_PK(d, k) (bf16x8){lo[d][k][0], lo[d][k][1], lo[d][k][2], lo[d][k][3], hi[d][k][0], hi[d][k][1], hi[d][k][2], hi[d][k][3]}
    asm volatile("s_waitcnt lgkmcnt(8)" : "+v"(lo[0][0]), "+v"(lo[0][1]), "+v"(lo[0][2]), "+v"(lo[0][3]), "+v"(hi[0][0]), "+v"(hi[0][1]), "+v"(hi[0][2]), "+v"(hi[0][3]) :: "memory"); __builtin_amdgcn_sched_barrier(0);
    o[0] = ATT_MFMA(pa0, ATT_PK(0, 0), o[0]); o[0] = ATT_MFMA(pa1, ATT_PK(0, 1), o[0]); o[0] = ATT_MFMA(pa2, ATT_PK(0, 2), o[0]); o[0] = ATT_MFMA(pa3, ATT_PK(0, 3), o[0]);
    asm volatile("s_waitcnt lgkmcnt(0)" : "+v"(lo[1][0]), "+v"(lo[1][1]), "+v"(lo[1][2]), "+v"(lo[1][3]), "+v"(hi[1][0]), "+v"(hi[1][1]), "+v"(hi[1][2]), "+v"(hi[1][3]) :: "memory"); __builtin_amdgcn_sched_barrier(0);
    o[1] = ATT_MFMA(pa0, ATT_PK(1, 0), o[1]); o[1] = ATT_MFMA(pa1, ATT_PK(1, 1), o[1]); o[1] = ATT_MFMA(pa2, ATT_PK(1, 2), o[1]); o[1] = ATT_MFMA(pa3, ATT_PK(1, 3), o[1]);
#undef ATT_PK
}
template <int MODE, bool EARLY>
__device__ __forceinline__ void attn_unit_impl(char* shm, int b, int h, int qb, const Args& A, const int wv, const bool pre, const bool hn, const int nb, const int nh, const int nqb) {
    constexpr int NQ = (MODE == MLA) ? 6 : 4;
    constexpr int LDQ = (MODE == MLA) ? 384 : NMIX, HQS = (MODE == MLA) ? 96 : 64, LDK = (MODE == MLA) ? 256 : NMIX, LDV = LDK;
    constexpr bool LS = (MODE != SB);
    constexpr float THR = 8.f;
    int sh_bits = 0, st_bits = (int)0x42B40000; unsigned pass = 0u; bool pre_l = pre;
    volatile unsigned* ovfw = (volatile unsigned*)(shm + LDS_FLAG + 16);
    if (wv == 0 && lane_id() == 4) *ovfw = 0u;
retry_unit:
    const float shift = __uint_as_float((unsigned)__builtin_amdgcn_readfirstlane(sh_bits));
    int tid_ = (wv << 6) | lane_id(); asm volatile("" : "+v"(tid_));
    const int tid = tid_, lane = tid & 63, r32 = lane & 31, hi = lane >> 5; const int wid = wv;
    const long rowbase = (long)b * SEQ; const int q0 = qb * 256; const int bh = b * 4 + h;
    const unsigned lds0 = (unsigned)(uintptr_t)shm;
    float* wsf = (float*)(shm + LDS_WS) + wid * 64;
    const bf16_t* Qw = A.Q + (rowbase + q0 + wid * 32) * LDQ + h * HQS;
    const bf16_t* Kh = A.K + rowbase * LDK + h * 64; const bf16_t* Vh = A.V + rowbase * LDV + h * 64;
    const bf16_t* ksrc = Kh + (long)lane * LDK + wid * 8;
    const bf16_t* ksrc2 = (MODE == MLA) ? A.K2 + (rowbase + lane) * 32 + (wid & 3) * 8 : (MODE == FOX) ? A.K2 + ((long)bh * SEQ + lane) * 8 : nullptr;
    const bf16_t* vsrc = Vh + (long)(16 * (wid & 3) + (lane >> 2)) * LDV + (wid >> 2) * 32 + (lane & 3) * 8;
    const float* TBh = (MODE == FOX) ? A.TB + bh * 128 : nullptr; const float* KMh = (MODE == FOX) ? A.KMX + bh * 128 : nullptr;
    const int NT = (q0 + 256) / 64;
#define ATT_DMA_KX(KS, KS2, t, s) do { const long kt_ = (long)(t) * 64; \
        glds16((KS) + kt_ * LDK, (unsigned)__builtin_amdgcn_readfirstlane(lds0 + LDS_K + (s) * KSLOT + wid * 1024)); \
        if (MODE == MLA) { if (wid < 4) glds16((KS2) + kt_ * 32, (unsigned)__builtin_amdgcn_readfirstlane(lds0 + LDS_K + (s) * KSLOT + (8 + wid) * 1024)); } \
        if (MODE == FOX) { if (wid == 7) glds16((KS2) + kt_ * 8, (unsigned)__builtin_amdgcn_readfirstlane(lds0 + LDS_K + (s) * KSLOT + 8 * 1024)); } } while (0)
#define ATT_DMA_VX(VS, t, s) glds16((VS) + (long)(t) * 64 * LDV, (unsigned)__builtin_amdgcn_readfirstlane(lds0 + LDS_V + (s) * VSLOT + wid * 1024))
#define ATT_DMA_K(t, s) ATT_DMA_KX(ksrc, ksrc2, t, s)
#define ATT_DMA_V(t, s) ATT_DMA_VX(vsrc, t, s)
    if (!pre_l) { ATT_DMA_K(NT - 1, 0); ATT_DMA_V(NT - 1, 0); if (NT > 1) ATT_DMA_K(NT - 2, 1); }
    bf16x8 qr[NQ];
#pragma unroll
    for (int d0 = 0; d0 < NQ; ++d0) qr[d0] = *reinterpret_cast<const bf16x8*>(&Qw[(long)r32 * LDQ + d0 * 16 + hi * 8]);
    const bf16x8 qone = (hi == 0) ? (bf16x8){(short)0x3F80, (short)0x3F80, 0, 0, 0, 0, 0, 0} : (bf16x8){0, 0, 0, 0, 0, 0, 0, 0};
    const bf16x8 ones = {(short)0x3F80, (short)0x3F80, (short)0x3F80, (short)0x3F80, (short)0x3F80, (short)0x3F80, (short)0x3F80, (short)0x3F80};
    const int qg = q0 + wid * 32 + r32;
    float qn = 0.f;
    if (MODE == FOX) {
#pragma unroll
        for (int d0 = 0; d0 < 4; ++d0)
#pragma unroll
            for (int j = 0; j < 8; ++j) { const float v = __uint_as_float(((unsigned)(unsigned short)qr[d0][j]) << 16); qn += v * v; }
        qn = x32_sum(qn); qn = sqrtf(qn) * 1.0001f; }
    f32x16 o[2]; o[0] = f32x16{}; o[1] = f32x16{};
    f32x16 lacc = f32x16{};
    f32x16 ng = f32x16{};
    float lrun = 0.f; float mrun = -INFINITY, Rrun = 0.f;
    float mused = 0.f, mused_n = 0.f;
    const int vb0 = (int)(lds0 + LDS_V) + ((lane >> 4) & 1) * 32 + (lane & 3) * 8 + (4 * hi + ((lane & 15) >> 2)) * 64;
    volatile unsigned char* flags = (volatile unsigned char*)(shm + LDS_FLAG);
    if (MODE != MLA) { if (tid < 4) ((volatile unsigned*)flags)[tid] = 0u; }
    float* tbs = (float*)(shm + LDS_TB);
    if (MODE == FOX) { if (tid < 128) tbs[tid] = TBh[tid]; else if (tid < 256) tbs[tid] = KMh[tid - 128]; }
    f32x16 p0, p1, n0, n1;
#define ATT_KRD(dst, areg, off) asm volatile("ds_read_b128 %0, %1 offset:%c2" : "=&v"(dst) : "v"(areg), "i"(off) : "memory")
#define ATT_QK(D0, D1, ks, CT) do { const unsigned ka_ = lds0 + LDS_K + (ks) * KSLOT + hi * 1024 + r32 * 16; bf16x8 kf_[2 * NQ]; bf16x8 kx0_, kx1_; \
        _Pragma("unroll") for (int d0 = 0; d0 < NQ; ++d0) { ATT_KRD(kf_[2 * d0], ka_, d0 * 2048); ATT_KRD(kf_[2 * d0 + 1], ka_, d0 * 2048 + 512); } \
        if (MODE == FOX) { const unsigned kb_ = lds0 + LDS_K + (ks) * KSLOT + 8 * 1024 + r32 * 16; ATT_KRD(kx0_, kb_, 0); ATT_KRD(kx1_, kb_, 512); } \
        if (MODE == MLA) asm volatile("s_waitcnt lgkmcnt(6)" : "+v"(kf_[0]), "+v"(kf_[1]), "+v"(kf_[2]), "+v"(kf_[3]), "+v"(kf_[4]), "+v"(kf_[5]) :: "memory"); \
        else if (MODE == FOX) asm volatile("s_waitcnt lgkmcnt(6)" : "+v"(kf_[0]), "+v"(kf_[1]), "+v"(kf_[2]), "+v"(kf_[3]) :: "memory"); \
        else asm volatile("s_waitcnt lgkmcnt(4)" : "+v"(kf_[0]), "+v"(kf_[1]), "+v"(kf_[2]), "+v"(kf_[3]) :: "memory"); \
        __builtin_amdgcn_sched_barrier(0); \
        D0 = ATT_MFMA(kf_[0], qr[0], CT); D1 = ATT_MFMA(kf_[1], qr[0], CT); D0 = ATT_MFMA(kf_[2], qr[1], D0); D1 = ATT_MFMA(kf_[3], qr[1], D1); \
        if (MODE == MLA) { D0 = ATT_MFMA(kf_[4], qr[2], D0); D1 = ATT_MFMA(kf_[5], qr[2], D1); \
            asm volatile("s_waitcnt lgkmcnt(0)" : "+v"(kf_[6]), "+v"(kf_[7]), "+v"(kf_[8]), "+v"(kf_[9]), "+v"(kf_[10]), "+v"(kf_[11]) :: "memory"); __builtin_amdgcn_sched_barrier(0); \
            _Pragma("unroll") for (int d0 = 3; d0 < NQ; ++d0) { D0 = ATT_MFMA(kf_[2 * d0], qr[d0], D0); D1 = ATT_MFMA(kf_[2 * d0 + 1], qr[d0], D1); } } \
        else if (MODE == FOX) { asm volatile("s_waitcnt lgkmcnt(0)" : "+v"(kf_[4]), "+v"(kf_[5]), "+v"(kf_[6]), "+v"(kf_[7]), "+v"(kx0_), "+v"(kx1_) :: "memory"); __builtin_amdgcn_sched_barrier(0); \
            D0 = ATT_MFMA(kf_[4], qr[2], D0); D1 = ATT_MFMA(kf_[5], qr[2], D1); D0 = ATT_MFMA(kf_[6], qr[3], D0); D1 = ATT_MFMA(kf_[7], qr[3], D1); D0 = ATT_MFMA(kx0_, qone, D0); D1 = ATT_MFMA(kx1_, qone, D1); } \
        else { asm volatile("s_waitcnt lgkmcnt(0)" : "+v"(kf_[4]), "+v"(kf_[5]), "+v"(kf_[6]), "+v"(kf_[7]) :: "memory"); __builtin_amdgcn_sched_barrier(0); \
            D0 = ATT_MFMA(kf_[4], qr[2], D0); D1 = ATT_MFMA(kf_[5], qr[2], D1); D0 = ATT_MFMA(kf_[6], qr[3], D0); D1 = ATT_MFMA(kf_[7], qr[3], D1); } } while (0)
#define ATT_NEXT(tn, fast) do { float tbn_ = 0.f; if (MODE == FOX) tbn_ = tbs[(tn)]; \
        if ((fast) && MODE != SB) { const float mref_ = mrun + shift, c_ = tbn_ - mref_; _Pragma("unroll") for (int r = 0; r < 16; ++r) ng[r] = c_; asm volatile("" : "+v"(ng)); mused_n = mref_; } else mused_n = tbn_; \
        ATT_QK(n0, n1, ksn, ng); } while (0)
#define MX3(a, b, c) __builtin_fmaxf(__builtin_fmaxf((a), (b)), (c))
    asm volatile("s_waitcnt vmcnt(0) lgkmcnt(0)\n\ts_barrier" ::: "memory");
    ATT_QK(p0, p1, 0, ng); if (MODE == FOX) mused = tbs[NT - 1];
    int ksn = 1, ksp = 2;
    auto tile = [&](f32x16& p0, f32x16& p1, float& mused, f32x16& n0, f32x16& n1, float& mused_n, const int it) __attribute__((always_inline)) -> bool {
        const int t = NT - 1 - it, vs = it & 1;
        if (it > 0) {
            asm volatile("s_waitcnt vmcnt(0) lgkmcnt(0)\n\ts_barrier" ::: "memory");
            if (MODE != MLA) { if (*(volatile unsigned long long*)(flags + ((it - 1) & 1) * 8) == 0x0101010101010101ull) return true; }
        }
        if (it + 2 < NT) ATT_DMA_K(t - 2, ksp);
        if (it + 1 < NT) ATT_DMA_V(t - 1, vs ^ 1);
        const bool fastn = (it >= 3);
        if (EARLY) { if (it + 1 < NT) ATT_NEXT(t - 1, fastn && it >= 4); }
        {
            const int kbase = 64 * t + 4 * hi;
            if (MODE != SB) {
                float tbt = 0.f; if (MODE == FOX) tbt = tbs[t];
                if (it < 4) {
#pragma unroll
                    for (int r = 0; r < 16; ++r) { const int kv = kbase + (r & 3) + 8 * (r >> 2); if (kv > qg) p0[r] = -INFINITY; if (kv + 32 > qg) p1[r] = -INFINITY; }
                    float rm = fmaxf(p0[0], p1[0]);
#pragma unroll
                    for (int r = 1; r < 16; ++r) rm = fmaxf(rm, fmaxf(p0[r], p1[r]));
                    rm = x32_max(rm);
                    const float rma = rm + mused;
                    if (__any(rma > mrun)) {
                        const float mnew = fmaxf(mrun, rma), alpha = (mrun == -INFINITY) ? 1.f : fast_exp2(mrun - mnew); mrun = mnew; lrun *= alpha;
                        if (hi == 0) wsf[r32] = alpha;
                        LDS_WAIT();
#pragma unroll
                        for (int g = 0; g < 4; ++g) { const f32x4 a4 = *(const f32x4*)(wsf + 8 * g + 4 * hi);
#pragma unroll
                            for (int i = 0; i < 4; ++i) { o[0][4 * g + i] *= a4[i]; o[1][4 * g + i] *= a4[i]; if (LS) lacc[4 * g + i] *= a4[i]; } }
                    }
                    const float mrel = ((mrun == -INFINITY) ? 0.f : mrun + shift) - mused;
#pragma unroll
                    for (int r = 0; r < 16; ++r) { p0[r] = fast_exp2(p0[r] - mrel); p1[r] = fast_exp2(p1[r] - mrel); }
                    if (!LS) { float sa = 0.f;
#pragma unroll
                        for (int r = 0; r < 16; ++r) sa += p0[r] + p1[r];
                        lrun += sa; }
                } else {
                    const float sub = (mrun + shift) - mused;
                    if (__any(sub != 0.f)) {
#pragma unroll
                        for (int r = 0; r < 16; ++r) { p0[r] = fast_exp2(p0[r] - sub); p1[r] = fast_exp2(p1[r] - sub); }
                    } else {
#pragma unroll
                        for (int r = 0; r < 16; ++r) { p0[r] = fast_exp2(p0[r]); p1[r] = fast_exp2(p1[r]); }
                    }
                }
                if (MODE == FOX) {
                    int done = 0; if (t > 0) done = __all(qn * tbs[128 + t - 1] + tbs[t - 1] - (mrun + shift) < -150.f) ? 1 : 0;
                    if (lane == 0) flags[(it & 1) * 8 + wid] = (unsigned char)done; }
                (void)tbt;
            } else {
                f32x16 l0, l1;
#pragma unroll
                for (int r = 0; r < 16; ++r) { const int kv = kbase + (r & 3) + 8 * (r >> 2);
                    { const float z = p0[r], sp = fmaxf(z, 0.f) + fast_log2(1.f + fast_exp2(-fabsf(z))); const bool ok = kv < qg; l0[r] = ok ? -sp : 0.f; p0[r] = ok ? z - sp : -INFINITY; }
                    { const float z = p1[r], sp = fmaxf(z, 0.f) + fast_log2(1.f + fast_exp2(-fabsf(z))); const bool ok = kv + 32 < qg; l1[r] = ok ? -sp : 0.f; p1[r] = ok ? z - sp : -INFINITY; } }
                float gs[8], og[8];
#pragma unroll
                for (int g = 0; g < 4; ++g) { gs[g] = (l0[4 * g] + l0[4 * g + 1]) + (l0[4 * g + 2] + l0[4 * g + 3]); gs[4 + g] = (l1[4 * g] + l1[4 * g + 1]) + (l1[4 * g + 2] + l1[4 * g + 3]); }
#pragma unroll
                for (int g = 0; g < 8; ++g) og[g] = x32_other(gs[g], hi);
                float run = Rrun;
#pragma unroll
                for (int g = 7; g >= 0; --g) {
                    const float aft = run + (hi == 0 ? og[g] : 0.f);
                    if (g >= 4) { const int r = 4 * (g - 4); float c = aft; p1[r + 3] = fast_exp2(p1[r + 3] + c); c += l1[r + 3]; p1[r + 2] = fast_exp2(p1[r + 2] + c); c += l1[r + 2]; p1[r + 1] = fast_exp2(p1[r + 1] + c); c += l1[r + 1]; p1[r] = fast_exp2(p1[r] + c); }
                    else        { const int r = 4 * g;       float c = aft; p0[r + 3] = fast_exp2(p0[r + 3] + c); c += l0[r + 3]; p0[r + 2] = fast_exp2(p0[r + 2] + c); c += l0[r + 2]; p0[r + 1] = fast_exp2(p0[r + 1] + c); c += l0[r + 1]; p0[r] = fast_exp2(p0[r] + c); }
                    run += gs[g] + og[g];
                }
                Rrun = run;
                const int done = __all(Rrun < -160.f) ? 1 : 0;
                if (lane == 0) flags[(it & 1) * 8 + wid] = (unsigned char)done;
            }
            const bf16x8 pa0 = __builtin_bit_cast(bf16x8, (u32x4){cvt_pk_bf16(p0[0], p0[1]), cvt_pk_bf16(p0[2], p0[3]), cvt_pk_bf16(p0[4], p0[5]), cvt_pk_bf16(p0[6], p0[7])});
            const bf16x8 pa1 = __builtin_bit_cast(bf16x8, (u32x4){cvt_pk_bf16(p0[8], p0[9]), cvt_pk_bf16(p0[10], p0[11]), cvt_pk_bf16(p0[12], p0[13]), cvt_pk_bf16(p0[14], p0[15])});
            const bf16x8 pa2 = __builtin_bit_cast(bf16x8, (u32x4){cvt_pk_bf16(p1[0], p1[1]), cvt_pk_bf16(p1[2], p1[3]), cvt_pk_bf16(p1[4], p1[5]), cvt_pk_bf16(p1[6], p1[7])});
            const bf16x8 pa3 = __builtin_bit_cast(bf16x8, (u32x4){cvt_pk_bf16(p1[8], p1[9]), cvt_pk_bf16(p1[10], p1[11]), cvt_pk_bf16(p1[12], p1[13]), cvt_pk_bf16(p1[14], p1[15])});
            pv(o, vb0 + vs * VSLOT, pa0, pa1, pa2, pa3);
            if (LS) { lacc = ATT_MFMA(pa0, ones, lacc); lacc = ATT_MFMA(pa1, ones, lacc); lacc = ATT_MFMA(pa2, ones, lacc); lacc = ATT_MFMA(pa3, ones, lacc); }
        }
        if (!EARLY) { if (it + 1 < NT) ATT_NEXT(t - 1, fastn); }
        ksn = ksp; ksp = (ksp == 2) ? 0 : ksp + 1;
        return false;
    };
    for (int it = 0; it < NT; it += 2) {
        if (tile(p0, p1, mused, n0, n1, mused_n, it)) break;
        if (tile(n0, n1, mused_n, p0, p1, mused, it + 1)) break;
    }
    if (MODE != SB) {
        bool okv = true;
#pragma unroll
        for (int r = 0; r < 16; ++r) okv = okv && (lacc[r] < 1.2e30f) && (fabsf(o[0][r]) < 1.2e30f) && (fabsf(o[1][r]) < 1.2e30f);
        if (!okv) *ovfw = pass + 1u;
    }
    asm volatile("s_waitcnt lgkmcnt(0)\n\ts_barrier" ::: "memory");
    if (MODE != SB) { if (*ovfw == pass + 1u) { ++pass; sh_bits = __builtin_amdgcn_readfirstlane((int)__float_as_uint(shift + __uint_as_float((unsigned)st_bits))); st_bits = __builtin_amdgcn_readfirstlane((int)__float_as_uint(2.f * __uint_as_float((unsigned)st_bits))); pre_l = false; goto retry_unit; } }
    if (hn) {
        const long nrow = (long)nb * SEQ; const int nbh = nb * 4 + nh, NTn = (nqb * 256 + 256) / 64;
        const bf16_t* nks = A.K + nrow * LDK + nh * 64 + (long)lane * LDK + wid * 8;
        const bf16_t* nks2 = (MODE == MLA) ? A.K2 + (nrow + lane) * 32 + (wid & 3) * 8 : (MODE == FOX) ? A.K2 + ((long)nbh * SEQ + lane) * 8 : nullptr;
        const bf16_t* nvs = A.V + nrow * LDV + nh * 64 + (long)(16 * (wid & 3) + (lane >> 2)) * LDV + (wid >> 2) * 32 + (lane & 3) * 8;
        ATT_DMA_KX(nks, nks2, NTn - 1, 0); ATT_DMA_VX(nvs, NTn - 1, 0); if (NTn > 1) ATT_DMA_KX(nks, nks2, NTn - 2, 1);
    }
    bf16_t* Ow = A.O + (rowbase + q0 + wid * 32) * DM + h * 64;
    { __hip_bfloat16* stg = (__hip_bfloat16*)(shm + LDS_OST) + wid * 2048;
#pragma unroll
        for (int r = 0; r < 16; ++r) { const int orow = crow(r, hi); const float rl = LS ? fast_rcp(lacc[r]) : 1.f;
#pragma unroll
            for (int d0 = 0; d0 < 2; ++d0) stg[orow * 64 + d0 * 32 + r32] = __float2bfloat16(o[d0][r] * rl); }
        LDS_WAIT();
#pragma unroll
        for (int i = 0; i < 4; ++i) { const int row = i * 8 + (lane >> 3), ch = lane & 7; const u32x4 v = *(const u32x4*)(stg + row * 64 + ch * 8); *(u32x4*)(Ow + (long)row * DM + ch * 8) = v; } }
    if (!hn) asm volatile("s_waitcnt vmcnt(0) lgkmcnt(0)\n\ts_barrier" ::: "memory");
#undef ATT_DMA_KX
#undef ATT_DMA_VX
#undef ATT_DMA_K
#undef ATT_DMA_V
#undef ATT_QK
#undef ATT_KRD
#undef ATT_NEXT
#undef MX3
}
template <int MODE>
__device__ __forceinline__ void attn_unit(char* shm, int b, int h, int qb, const Args& A, const int wv, const bool pre, const bool hn, const int nb, const int nh, const int nqb) {
    if (wv < 4) attn_unit_impl<MODE, true>(shm, b, h, qb, A, wv, pre, hn, nb, nh, nqb); else attn_unit_impl<MODE, false>(shm, b, h, qb, A, wv, pre, hn, nb, nh, nqb);
}
#undef ATT_MFMA
}

namespace hg {
constexpr int PF = 68;
constexpr int PD = 72, PS_ = 40;
constexpr int B_QX = 0, B_KDT = B_QX + 32 * PD * 2, B_VT = B_KDT + 64 * PS_ * 2, B_ST = B_VT + 64 * PS_ * 2, B_SC = B_ST + 64 * PD * 2, B_Q1 = B_SC + 32 * PS_ * 2, B_K0 = B_Q1 + 16 * PD * 2,
    B_QR = B_K0 + 16 * PD * 2, B_KR = B_QR + 32 * PF * 4, B_BC = B_KR + 32 * PF * 4, B_G = B_BC + 32 * PF * 4, B_BL = B_G + 32 * PF * 4, B_PS = B_BL + 256, B_QD = B_PS + 512, B_K1 = B_QD + 32 * PD * 2, B_OVF = B_K1 + 16 * PD * 2, B_END = B_OVF + 16;
static_assert(B_END <= RING_BYTES && (B_QR % 16) == 0 && (B_KDT % 16) == 0 && (B_SC % 16) == 0 && (B_QD % 16) == 0 && (B_K1 % 16) == 0, "HGRN scratch");
struct Args { const bf16_t* MIX; const float* lb_logits; const float* out_norm; float* SLOC; float* LSEG; bf16_t* YS; int layer; };
struct Raw { u32x2 q, f, i, g; };
#define HG_MFMA(a, b, c) __builtin_amdgcn_mfma_f32_16x16x32_bf16(a, b, c, 0, 0, 0)
#define HG_SYNC() asm volatile("s_waitcnt lgkmcnt(0)\n\ts_barrier" ::: "memory")
template <bool STAGE2>
__device__ __forceinline__ void load_raw(Raw& R, const Args& A, long row0, int h, int wid, int lane) {
    const bf16_t* src = A.MIX + (row0 + (lane & 31)) * NMIX + 64 * h + 8 * wid + 4 * (lane >> 5);
    R.f = *(const u32x2*)(src + MX_HF); R.i = *(const u32x2*)(src + MX_HI);
    if (STAGE2) { R.q = *(const u32x2*)(src + MX_HQ); R.g = *(const u32x2*)(src + MX_HG); }
}
__device__ __forceinline__ void st_bf16(LAS unsigned char* L, int byteoff, float v) { *(LAS bf16_t*)(L + byteoff) = (bf16_t)(cvt_pk_bf16(v, 0.f) & 0xffffu); }
template <bool STAGE2>
__device__ __forceinline__ void transform(LAS unsigned char* L, const Raw& R, const float (&lbv)[4], float (&seglog)[4], int wid, int lane, int cpar = 0) {
    const int t = lane & 31, d0 = 8 * wid + 4 * (lane >> 5);
    const float hf[4] = {bf_lo(R.f.x), bf_hi(R.f.x), bf_lo(R.f.y), bf_hi(R.f.y)}, v[4] = {bf_lo(R.i.x), bf_hi(R.i.x), bf_lo(R.i.y), bf_hi(R.i.y)};
    float k[4], bc[4];
#pragma unroll
    for (int i = 0; i < 4; ++i) { const float f = lbv[i] + (1.f - lbv[i]) * sigmoidf_(hf[i]); k[i] = 1.f - f; bc[i] = fast_log2(f); }
#define HG_DPP(v, ctrl, rmask, bc_) __uint_as_float((unsigned)__builtin_amdgcn_update_dpp(0, (int)__float_as_uint(v), ctrl, rmask, 0xf, bc_))
#pragma unroll
    for (int i = 0; i < 4; ++i) { float v = bc[i];
        v += HG_DPP(v, 0x111, 0xf, true); v += HG_DPP(v, 0x112, 0xf, true); v += HG_DPP(v, 0x114, 0xf, true); v += HG_DPP(v, 0x118, 0xf, true);
        v += HG_DPP(v, 0x142, 0xa, false); bc[i] = v; }
#undef HG_DPP
    float bl[4], b15[4];
#pragma unroll
    for (int i = 0; i < 4; ++i) { const int vi = (int)__float_as_uint(bc[i]);
        const float e0 = __uint_as_float((unsigned)__builtin_amdgcn_readlane(vi, 31)), e1 = __uint_as_float((unsigned)__builtin_amdgcn_readlane(vi, 63));
        const float f0 = __uint_as_float((unsigned)__builtin_amdgcn_readlane(vi, 15)), f1 = __uint_as_float((unsigned)__builtin_amdgcn_readlane(vi, 47));
        bl[i] = (lane & 32) ? e1 : e0; b15[i] = (lane & 32) ? f1 : f0; }
#pragma unroll
    for (int i = 0; i < 4; ++i) { st_bf16(L, B_KDT + ((d0 + i) * PS_ + t) * 2, k[i] * fast_exp2(bl[i] - bc[i])); st_bf16(L, B_VT + ((d0 + i) * PS_ + t) * 2, v[i]); }
    if (t == 31) { *(LAS f32x4*)(L + B_BL + d0 * 4) = (f32x4){fast_exp2(bl[0]), fast_exp2(bl[1]), fast_exp2(bl[2]), fast_exp2(bl[3])};
#pragma unroll
        for (int i = 0; i < 4; ++i) seglog[i] += bl[i]; }
    if (STAGE2) {
        const float q[4] = {bf_lo(R.q.x), bf_hi(R.q.x), bf_lo(R.q.y), bf_hi(R.q.y)}, g[4] = {bf_lo(R.g.x), bf_hi(R.g.x), bf_lo(R.g.y), bf_hi(R.g.y)};
        { u32x2 w; w.x = cvt_pk_bf16(q[0] * fast_exp2(bc[0]), q[1] * fast_exp2(bc[1])); w.y = cvt_pk_bf16(q[2] * fast_exp2(bc[2]), q[3] * fast_exp2(bc[3])); *(LAS u32x2*)(L + B_QX + (t * PD + d0) * 2) = w; }
        { const bool up = t >= 16; float z[4];
#pragma unroll
          for (int i = 0; i < 4; ++i) { const float dl = bc[i] - b15[i]; z[i] = (up ? q[i] : k[i]) * fast_exp2(up ? dl : -dl); }
          u32x2 w; w.x = cvt_pk_bf16(z[0], z[1]); w.y = cvt_pk_bf16(z[2], z[3]); *(LAS u32x2*)(L + (up ? B_Q1 - 16 * PD * 2 : B_K0) + (t * PD + d0) * 2) = w; }
        {
          const bool up = t >= 16; float zq[4]; bool steep = false;
#pragma unroll
          for (int i = 0; i < 4; ++i) { const float e = bc[i] - (up ? bl[i] : b15[i]); steep = steep || !(e < 120.f); zq[i] = q[i] * fast_exp2(e); }
          u32x2 w; w.x = cvt_pk_bf16(zq[0], zq[1]); w.y = cvt_pk_bf16(zq[2], zq[3]); *(LAS u32x2*)(L + B_QD + (t * PD + d0) * 2) = w;
          if (up) { u32x2 w1; w1.x = cvt_pk_bf16(k[0] * fast_exp2(bl[0] - bc[0]), k[1] * fast_exp2(bl[1] - bc[1])); w1.y = cvt_pk_bf16(k[2] * fast_exp2(bl[2] - bc[2]), k[3] * fast_exp2(bl[3] - bc[3])); *(LAS u32x2*)(L + B_K1 + ((t - 16) * PD + d0) * 2) = w1; }
          if (steep) *(volatile LAS unsigned*)(L + B_OVF + 4 * cpar) = 1u; }
        *(LAS f32x4*)(L + B_QR + (t * PF + d0) * 4) = (f32x4){q[0], q[1], q[2], q[3]}; *(LAS f32x4*)(L + B_KR + (t * PF + d0) * 4) = (f32x4){k[0], k[1], k[2], k[3]};
        *(LAS f32x4*)(L + B_BC + (t * PF + d0) * 4) = (f32x4){bc[0], bc[1], bc[2], bc[3]};
        *(LAS f32x4*)(L + B_G + (t * PF + d0) * 4) = (f32x4){g[0] * sigmoidf_(g[0]), g[1] * sigmoidf_(g[1]), g[2] * sigmoidf_(g[2]), g[3] * sigmoidf_(g[3])};
    }
}
__device__ __forceinline__ void state_update(LAS unsigned char* L, f32x4 (&S)[2], int wid, int lane, bool mma) {
    const int dm = wid >> 1, lr = lane & 15, lq = lane >> 4;
    if (mma) {
        const f32x4 e = *(LAS f32x4*)(L + B_BL + (16 * dm + 4 * lq) * 4);
        const bf16x8 a = *(LAS bf16x8*)(L + B_KDT + ((16 * dm + lr) * PS_ + 8 * lq) * 2);
#pragma unroll
        for (int x = 0; x < 2; ++x) { const int vn = 2 * (wid & 1) + x; const bf16x8 b = *(LAS bf16x8*)(L + B_VT + ((16 * vn + lr) * PS_ + 8 * lq) * 2);
            S[x] = S[x] * e; S[x] = HG_MFMA(a, b, S[x]); }
    }
#pragma unroll
    for (int x = 0; x < 2; ++x) { const int vn = 2 * (wid & 1) + x; u32x2 w; w.x = cvt_pk_bf16(S[x][0], S[x][1]); w.y = cvt_pk_bf16(S[x][2], S[x][3]);
        *(LAS u32x2*)(L + B_ST + ((16 * vn + lr) * PD + 16 * dm + 4 * lq) * 2) = w; }
}
__device__ __forceinline__ void lower_bounds(const Args& A, int h, int d0, float (&lbv)[4]) {
#pragma unroll
    for (int i = 0; i < 4; ++i) { const int c = 64 * h + d0 + i; float lg[4], mx = -INFINITY;
#pragma unroll
        for (int l = 0; l < 4; ++l) { lg[l] = A.lb_logits[l * 256 + c]; mx = fmaxf(mx, lg[l]); }
        float den = 0.f, num = 0.f;
#pragma unroll
        for (int l = 0; l < 4; ++l) { const float e = __expf(lg[l] - mx); den += e; if (l >= 1 && l <= A.layer) num += e; }
        lbv[i] = num / den; }
}
__device__ __forceinline__ void stage1_unit(LAS unsigned char* L, const Args& A, int bh, int seg, const int wv) {
    int tid_ = (wv << 6) | lane_id(); asm volatile("" : "+v"(tid_));
    const int tid = tid_, lane = tid & 63, wid = wv;
    const int h = bh & 3; const long row0 = (long)(bh >> 2) * SEQ + seg * 256; const int d0 = 8 * wid + 4 * (lane >> 5);
    float lbv[4]; lower_bounds(A, h, d0, lbv);
    float seglog[4] = {0.f, 0.f, 0.f, 0.f};
    f32x4 S[2]; S[0] = (f32x4){0.f, 0.f, 0.f, 0.f}; S[1] = S[0];
    Raw R; load_raw<false>(R, A, row0, h, wid, lane);
    for (int c = 0; c < 8; ++c) {
        transform<false>(L, R, lbv, seglog, wid, lane);
        if (c + 1 < 8) load_raw<false>(R, A, row0 + 32 * (c + 1), h, wid, lane);
        HG_SYNC();
        state_update(L, S, wid, lane, true);
        HG_SYNC();
    }
    const int u = bh * 32 + seg, dm = wid >> 1, lr = lane & 15, lq = lane >> 4;
#pragma unroll
    for (int x = 0; x < 2; ++x) { const int vn = 2 * (wid & 1) + x;
#pragma unroll
        for (int i = 0; i < 4; ++i) A.SLOC[((size_t)u * 64 + 16 * dm + 4 * lq + i) * 64 + 16 * vn + lr] = S[x][i]; }
    if ((lane & 31) == 31) { *(f32x4*)(A.LSEG + (size_t)u * 64 + d0) = (f32x4){seglog[0], seglog[1], seglog[2], seglog[3]}; }
}
__device__ __forceinline__ void stage2_unit(LAS unsigned char* L, const Args& A, int bh, int seg, const int wv) {
    int tid_ = (wv << 6) | lane_id(); asm volatile("" : "+v"(tid_));
    const int tid = tid_, lane = tid & 63, wid = wv;
    const int h = bh & 3; const long row0 = (long)(bh >> 2) * SEQ + seg * 256; const int d0 = 8 * wid + 4 * (lane >> 5);
    const int lr = lane & 15, lq = lane >> 4;
    float lbv[4]; lower_bounds(A, h, d0, lbv);
    float seglog[4] = {0.f, 0.f, 0.f, 0.f};
    f32x4 S[2]; S[0] = (f32x4){0.f, 0.f, 0.f, 0.f}; S[1] = S[0];
    Raw R; load_raw<true>(R, A, row0, h, wid, lane);
    {
        const int dm = wid >> 1;
        int j = 0;
        for (; j + 4 <= seg; j += 4) {
            f32x4 lg[4]; float loc[4][2][4];
#pragma unroll
            for (int q = 0; q < 4; ++q) { const int u = bh * 32 + j + q; lg[q] = *(const f32x4*)(A.LSEG + (size_t)u * 64 + 16 * dm + 4 * lq);
#pragma unroll
                for (int x = 0; x < 2; ++x) { const int vn = 2 * (wid & 1) + x;
#pragma unroll
                    for (int i = 0; i < 4; ++i) loc[q][x][i] = A.SLOC[((size_t)u * 64 + 16 * dm + 4 * lq + i) * 64 + 16 * vn + lr]; } }
#pragma unroll
            for (int q = 0; q < 4; ++q)
#pragma unroll
                for (int x = 0; x < 2; ++x)
#pragma unroll
                    for (int i = 0; i < 4; ++i) S[x][i] = S[x][i] * fast_exp2(lg[q][i]) + loc[q][x][i];
        }
        for (; j < seg; ++j) { const int u = bh * 32 + j; const f32x4 lg = *(const f32x4*)(A.LSEG + (size_t)u * 64 + 16 * dm + 4 * lq);
#pragma unroll
            for (int x = 0; x < 2; ++x) { const int vn = 2 * (wid & 1) + x;
#pragma unroll
                for (int i = 0; i < 4; ++i) S[x][i] = S[x][i] * fast_exp2(lg[i]) + A.SLOC[((size_t)u * 64 + 16 * dm + 4 * lq + i) * 64 + 16 * vn + lr]; } }
        state_update(L, S, wid, lane, false);
        for (int i = tid; i < 32 * PS_ / 2; i += 512) *(LAS unsigned*)(L + B_SC + i * 4) = 0u;
        if (tid < 2) *(volatile LAS unsigned*)(L + B_OVF + 4 * tid) = 0u;
        HG_SYNC();
    }
    const f32x4 gn4 = {A.out_norm[64 * h + 16 * (wid & 3) + lr], 0.f, 0.f, 0.f};
    for (int c = 0; c < 8; ++c) {
        const long crow0 = row0 + 32 * c;
        transform<true>(L, R, lbv, seglog, wid, lane, c & 1);
        if (c + 1 < 8) load_raw<true>(R, A, crow0 + 32, h, wid, lane);
        HG_SYNC();
        {
            const unsigned steep = *(volatile LAS unsigned*)(L + B_OVF + 4 * (c & 1));
            if (tid == 0) *(volatile LAS unsigned*)(L + B_OVF + 4 * ((c + 1) & 1)) = 0u;
            if (steep) {
            float sc = 0.f; int tt = 0, ss = 0;
            if (tid < 480) {
                const int blk = tid >= 240 ? 1 : 0, r = tid - 240 * blk, j = r >> 1, dh = r & 1; int tl, sl;
                if (j < 112) { const int rp = j >> 4, cc = j & 15; if (cc < rp + 1) { tl = rp + 1; sl = cc; } else { tl = 15 - rp; sl = cc - (rp + 1); } } else { tl = 8; sl = j - 112; }
                tt = 16 * blk + tl; ss = 16 * blk + sl;
                const LAS float* qp = (const LAS float*)(L + B_QR) + tt * PF + 32 * dh; const LAS float* kp = (const LAS float*)(L + B_KR) + ss * PF + 32 * dh;
                const LAS float* bt = (const LAS float*)(L + B_BC) + tt * PF + 32 * dh; const LAS float* bs = (const LAS float*)(L + B_BC) + ss * PF + 32 * dh;
#pragma unroll 1
                for (int h4 = 0; h4 < 2; ++h4) {
                    f32x4 q4[4], k4[4], b1[4], b2[4];
#pragma unroll
                    for (int d4 = 0; d4 < 4; ++d4) { q4[d4] = *(const LAS f32x4*)(qp + 16 * h4 + 4 * d4); k4[d4] = *(const LAS f32x4*)(kp + 16 * h4 + 4 * d4); b1[d4] = *(const LAS f32x4*)(bt + 16 * h4 + 4 * d4); b2[d4] = *(const LAS f32x4*)(bs + 16 * h4 + 4 * d4); }
#pragma unroll
                    for (int d4 = 0; d4 < 4; ++d4)
#pragma unroll
                        for (int i = 0; i < 4; ++i) sc += q4[d4][i] * k4[d4][i] * fast_exp2(b1[d4][i] - b2[d4][i]); }
            }
            const float other = lx<1>(sc);
            if (tid < 480) { if ((tid & 1) == 0) st_bf16(L, B_SC + (tt * PS_ + ss) * 2, sc + other); }
            { const int e = 4 * wid + (lane >> 4), dd = 4 * (lane & 15);
              const f32x4 q4 = *(const LAS f32x4*)(L + B_QR + (e * PF + dd) * 4), k4 = *(const LAS f32x4*)(L + B_KR + (e * PF + dd) * 4);
              float s = (q4[0] * k4[0] + q4[1] * k4[1]) + (q4[2] * k4[2] + q4[3] * k4[3]); s = row16_sum(s);
              if ((lane & 15) == 0) st_bf16(L, B_SC + (e * PS_ + e) * 2, s); }
            } else if (wid == 5 || wid == 6) {
                const int bk = wid - 5; f32x4 acc = {0.f, 0.f, 0.f, 0.f};
#pragma unroll
                for (int kk = 0; kk < 2; ++kk) { const bf16x8 a = *(LAS bf16x8*)(L + B_QD + ((16 * bk + lr) * PD + 8 * lq + 32 * kk) * 2), b = *(LAS bf16x8*)(L + (bk ? B_K1 : B_K0) + (lr * PD + 8 * lq + 32 * kk) * 2); acc = HG_MFMA(a, b, acc); }
#pragma unroll
                for (int i = 0; i < 4; ++i) st_bf16(L, B_SC + ((16 * bk + 4 * lq + i) * PS_ + 16 * bk + lr) * 2, (lr <= 4 * lq + i) ? acc[i] : 0.f);
            }
            if (wid == 7) {
                f32x4 acc = {0.f, 0.f, 0.f, 0.f};
#pragma unroll
                for (int kk = 0; kk < 2; ++kk) { const bf16x8 a = *(LAS bf16x8*)(L + B_Q1 + (lr * PD + 8 * lq + 32 * kk) * 2), b = *(LAS bf16x8*)(L + B_K0 + (lr * PD + 8 * lq + 32 * kk) * 2); acc = HG_MFMA(a, b, acc); }
#pragma unroll
                for (int i = 0; i < 4; ++i) st_bf16(L, B_SC + ((16 + 4 * lq + i) * PS_ + lr) * 2, acc[i]);
            }
        }
        HG_SYNC();
        f32x4 o = {0.f, 0.f, 0.f, 0.f};
        {
            const int tm = wid >> 2, vn = wid & 3;
            { const bf16x8 a = *(LAS bf16x8*)(L + B_SC + ((16 * tm + lr) * PS_ + 8 * lq) * 2), b = *(LAS bf16x8*)(L + B_VT + ((16 * vn + lr) * PS_ + 8 * lq) * 2); o = HG_MFMA(a, b, o); }
#pragma unroll
            for (int kk = 0; kk < 2; ++kk) { const bf16x8 a = *(LAS bf16x8*)(L + B_QX + ((16 * tm + lr) * PD + 8 * lq + 32 * kk) * 2), b = *(LAS bf16x8*)(L + B_ST + ((16 * vn + lr) * PD + 8 * lq + 32 * kk) * 2); o = HG_MFMA(a, b, o); }
            float s2v[4];
#pragma unroll
            for (int i = 0; i < 4; ++i) s2v[i] = row16_sum(o[i] * o[i]);
            if (lr < 4) *(LAS float*)(L + B_PS + ((16 * tm + 4 * lq + lr) * 4 + vn) * 4) = (lr == 0) ? s2v[0] : (lr == 1) ? s2v[1] : (lr == 2) ? s2v[2] : s2v[3];
        }
        HG_SYNC();
        { const int tm = wid >> 2, vn = wid & 3;
#pragma unroll
            for (int i = 0; i < 4; ++i) { const int t = 16 * tm + 4 * lq + i; const f32x4 ps = *(LAS f32x4*)(L + B_PS + t * 16);
                const float rs = __builtin_amdgcn_rsqf(((ps[0] + ps[1]) + (ps[2] + ps[3])) * (1.f / 64.f) + EPS); const float gt = *(LAS float*)(L + B_G + (t * PF + 16 * vn + lr) * 4);
                const float y = o[i] * rs * gn4[0] * gt;
                *(bf16_t*)(A.YS + (crow0 + t) * DM + 768 + 64 * h + 16 * vn + lr) = (bf16_t)(cvt_pk_bf16(y, 0.f) & 0xffffu); }
        }
        state_update(L, S, wid, lane, true);
        HG_SYNC();
    }
}
#undef HG_MFMA
#undef HG_SYNC
}

constexpr int N_PHASES = 50;
#ifndef MK_PER_PHASE
#define MK_PER_PHASE 0
#endif
struct KArgs { const float* in[20]; float* out; unsigned char* ws; int ph_lo, ph_hi, li, pad; };

__global__ void __launch_bounds__(NWAVES * 64, 2) fwd(KArgs a) {
    asm volatile("s_setreg_imm32_b32 hwreg(HW_REG_MODE, 23, 1), 1");
    extern __shared__ __attribute__((aligned(16))) unsigned char lds[];
    LAS unsigned char* L = (LAS unsigned char*)lds;
    volatile LAS unsigned* MISC = (volatile LAS unsigned*)(L + MISC_OFF);
    unsigned char* ws = a.ws;
    const int wv = __builtin_amdgcn_readfirstlane((int)threadIdx.x >> 6);
    for (int u = (wv << 6) | lane_id(); u < (LDS_BYTES - LDSCTL_OFF) / 4; u += NWAVES * 64) ((LAS unsigned*)(L + LDSCTL_OFF))[u] = 0u;
    __syncthreads();
    XcdBarrier bar = xcd_barrier_post((unsigned*)(ws + WS_CTL) + CW_BAR + a.li * XCD_BAR_WORDS, MISC + 8, wv == 0 && lane_id() == 0);
    const int lo = a.ph_lo, hi = a.ph_hi;
#ifndef EN_MASK
#define EN_MASK 0xFFFFFFFFu
#endif
#define EN(b) ((EN_MASK >> (b)) & 1u)
#define IN(k) (lo <= (k) && (k) < hi)
#define SEAM(k) do { if (IN(k) && IN((k) + 1)) xcd_barrier(bar, wv == 0 && lane_id() == 0); } while (0)
#define SEAM_L(k) do { if (IN(k) && IN((k) + 1)) { if (local_ok) xcd_barrier_local(bar, wv == 0 && lane_id() == 0); else xcd_barrier(bar, wv == 0 && lane_id() == 0); } } while (0)
    unsigned* xmask = (unsigned*)(ws + WS_CTL) + 64;
    if (wv == 0 && lane_id() == 0) (void)__hip_atomic_fetch_or(&xmask[blockIdx.x & 7], 1u << bar.x, __ATOMIC_RELAXED, __HIP_MEMORY_SCOPE_AGENT);
    bool local_ok = false;
#define DEFPTRS const __attribute__((address_space(4))) KArgs* ka = (const __attribute__((address_space(4))) KArgs*)__builtin_amdgcn_kernarg_segment_ptr(); asm volatile("" : "+s"(ka)); unsigned char* wsl = ka->ws; int tid = (wv << 6) | lane_id(); asm volatile("" : "+v"(tid)); const int lane = tid & 63, wave = wv; int bxl = blockIdx.x; asm volatile("" : "+s"(bxl)); const int G = gridDim.x; const int vcu = (G % 8 == 0) ? (bxl % 8) * (G / 8) + bxl / 8 : bxl; const int gw = vcu * NWAVES + wave, NGW = G * NWAVES; (void)lane; (void)gw; (void)NGW; float* SQ = (float*)(wsl + WS_SQ); float* ROPEC = (float*)(wsl + WS_ROPE); float* ROPES = ROPEC + SEQ * 16; float* LF = (float*)(wsl + WS_LF); bf16_t* KX = (bf16_t*)(wsl + WS_KX); float* TBA = (float*)(wsl + WS_TB); float* KMXA = TBA + 32 * 128; float* K2P = (float*)(wsl + WS_K2P); float* SLOC = (float*)(wsl + WS_HGS); float* LSEG = SLOC + (size_t)1024 * 4096; bf16_t* W = (bf16_t*)(wsl + WS_W); bf16_t* PB = (bf16_t*)(wsl + WS_PB); bf16_t* XB = (bf16_t*)(wsl + WS_XB); bf16_t* XBA = (bf16_t*)(wsl + WS_BIG + BIG_QM); bf16_t* YS = (bf16_t*)(wsl + WS_YS); bf16_t* MIX = (bf16_t*)(wsl + WS_BIG + BIG_MIX); bf16_t* QM = (bf16_t*)(wsl + WS_BIG + BIG_QM); bf16_t* KN = (bf16_t*)(wsl + WS_BIG + BIG_KN); bf16_t* VM = (bf16_t*)(wsl + WS_BIG + BIG_VM); bf16_t* KR = (bf16_t*)(wsl + WS_BIG + BIG_KR); bf16_t* PBUF = (bf16_t*)(wsl + WS_BIG); unsigned char* H8 = wsl + WS_BIG; unsigned char* X8 = wsl + WS_X8; unsigned char* X8B = wsl + WS_BIG + 192 * MiB; float* X = ka->out;

    if (EN(0) && IN(0)) { DEFPTRS;
        for (int idx = gw * 64 + lane; idx < SEQ * 16; idx += NGW * 64) {
            const int pos = idx >> 4, i = idx & 15;
            const double inv = exp2(-(double)i * (13.287712379549449 / 16.0));
            const double ang = (double)pos * inv;
            const double kq = rint(ang * 0.6366197723675814); const double y = fma(-kq, 1.5707963267948966, ang) - kq * 6.123233995736766e-17; const double y2 = y * y;
            const double sy = y * (1.0 + y2 * (-1.0 / 6 + y2 * (1.0 / 120 + y2 * (-1.0 / 5040 + y2 * (1.0 / 362880 + y2 * (-1.0 / 39916800 + y2 * (1.0 / 6227020800.0)))))));
            const double cy = 1.0 + y2 * (-0.5 + y2 * (1.0 / 24 + y2 * (-1.0 / 720 + y2 * (1.0 / 40320 + y2 * (-1.0 / 3628800 + y2 * (1.0 / 479001600.0))))));
            const int qd = ((int)((long long)kq & 3));
            const double sn = (qd == 0) ? sy : (qd == 1) ? cy : (qd == 2) ? -sy : -cy, cs = (qd == 0) ? cy : (qd == 1) ? -sy : (qd == 2) ? -cy : sy;
            ROPEC[idx] = (float)cs; ROPES[idx] = (float)sn;
        }
        const float* xin = ka->in[0];
        for (int row = gw; row < NTOK; row += 2 * NGW) {
            f32x4 v[2][4];
#pragma unroll
            for (int q = 0; q < 2; ++q)
#pragma unroll
                for (int j = 0; j < 4; ++j) v[q][j] = ((const f32x4*)(xin + (size_t)(row + q * NGW) * DM) + lane)[64 * j];
#pragma unroll
            for (int q = 0; q < 2; ++q) { const int r = row + q * NGW; unsigned long long* o8 = (unsigned long long*)(XBA + (size_t)r * DM) + lane; float s = 0.f;
#pragma unroll
                for (int j = 0; j < 4; ++j) { const f32x4 w = v[q][j]; s += (w[0] * w[0] + w[1] * w[1]) + (w[2] * w[2] + w[3] * w[3]);
                    const unsigned w0 = cvt_pk_bf16(w[0], w[1]), w1 = cvt_pk_bf16(w[2], w[3]); o8[64 * j] = (unsigned long long)w0 | ((unsigned long long)w1 << 32);
                    ((unsigned*)(X8 + (size_t)r * DM) + lane)[64 * j] = pk_fp8x4(bf_lo(w0), bf_hi(w0), bf_lo(w1), bf_hi(w1)); }
                s = wave_sum(s); if (lane < 16) SQ[(size_t)r * 16 + lane] = (lane == 0) ? s : 0.f; }
        }
    }
    SEAM(0);
    if (lo == 0 && hi == N_PHASES && gridDim.x == 256) {
        unsigned okm = 1u;
#pragma unroll
        for (int gq = 0; gq < 8; ++gq) { const unsigned m = xb_ld(&xmask[gq]); okm &= (m != 0u && (m & (m - 1u)) == 0u) ? 1u : 0u; }
        local_ok = __builtin_amdgcn_readfirstlane((int)okm) != 0;
    }

    for (int layer = 0; layer < DEPTH; ++layer) {
        const int pb = 1 + 12 * layer;
#define LAYERPTRS const float* norms = ka->in[18] + (size_t)layer * 4 * DM; float* sq0 = SQ; float* sq1 = SQ + (size_t)1 * NTOK * 16; float* sq2 = SQ + (size_t)2 * NTOK * 16; float* sq3 = SQ + (size_t)3 * NTOK * 16; float* sq4 = SQ; float* sqq = SQ + (size_t)4 * NTOK * 16; float* sqkv = sqq + (size_t)NTOK * 4; (void)sq0; (void)sq1; (void)sq2; (void)sq3; (void)sq4; (void)sqq; (void)sqkv; (void)norms;

        if (EN(1) && IN(pb + 0)) { DEFPTRS; LAYERPTRS;
            ConvCtx C; C.scr = (LAS float*)(L + wave * 16384); C.gw = gw; C.NGW = NGW; C.lane = lane; C.base = 0;
            conv_mat8(C, ka->in[12] + (size_t)layer * DM * 2 * FF, 2 * FF, DM, 2 * FF, norms + 0 * DM, (unsigned char*)(W + WO_FA1), MK_FFN1, 64.f);
            conv_mat8(C, ka->in[13] + (size_t)layer * FF * DM, DM, FF, DM, nullptr, (unsigned char*)(W + WO_FA2), MK_ID, 128.f);
            conv_mat8(C, ka->in[14] + (size_t)layer * DM * 2 * FF, 2 * FF, DM, 2 * FF, norms + 2 * DM, (unsigned char*)(W + WO_FB1), MK_FFN1, 64.f);
            conv_mat8(C, ka->in[15] + (size_t)layer * FF * DM, DM, FF, DM, nullptr, (unsigned char*)(W + WO_FB2), MK_ID, 128.f);
            conv_mat8(C, ka->in[2] + (size_t)layer * DM * INCOLS, INCOLS, DM, NMIX, norms + 1 * DM, (unsigned char*)(W + WO_MIX), MK_MIX, 64.f);
            conv_mat8(C, ka->in[2] + (size_t)layer * DM * INCOLS, INCOLS, DM, NGATE, norms + 1 * DM, (unsigned char*)(W + WO_GATE), MK_GATE, 64.f);
            conv_mat(C, ka->in[5] + (size_t)layer * 256 * 384, 384, 256, 256, 512, ka->in[4] + layer * 256, W + WO_UQ, MK_UQ);
            conv_mat(C, ka->in[7] + (size_t)layer * 128 * 512, 512, 128, 256, 512, ka->in[6] + layer * 128, W + WO_UKV, MK_ID);
            for (int nb = 0; nb < 4; ++nb) conv_mat(C, ka->in[10] + ((size_t)layer * 4 + nb) * 256 * DM, DM, 256, 256, DM, nullptr, W + WO_BR + (size_t)nb * DM * 256, MK_ID);
            conv_mat8(C, ka->in[11] + (size_t)layer * DM * DM, DM, DM, DM, nullptr, (unsigned char*)(W + WO_OUT), MK_ID, 64.f);
            conv_mat8(C, ka->in[17] + (size_t)layer * DM * DM, DM, DM, DM, norms + 3 * DM, (unsigned char*)(W + WO_PG), MK_ID, 64.f);
            conv_mat(C, ka->in[16] + (size_t)layer * PLE * DM, DM, PLE, PLE, DM, nullptr, W + WO_PE, MK_ID);
            const f32x4* ps = (const f32x4*)(ka->in[1] + (size_t)layer * NTOK * PLE); u32x2* pd = (u32x2*)PB;
            for (int i = gw * 64 + lane; i < NTOK * PLE / 4; i += NGW * 64) { const f32x4 v = ps[i]; u32x2 w; w.x = cvt_pk_bf16(v[0], v[1]); w.y = cvt_pk_bf16(v[2], v[3]); pd[i] = w; }
            LDS_WAIT(); __syncthreads();
        }
        SEAM(pb + 0);

        if (EN(2) && IN(pb + 1)) { DEFPTRS; LAYERPTRS;
            pg8::Gemm g{(const bf16_t*)X8, W + WO_FA1, NTOK, 2 * FF, DM / 2, DM / 2, DM / 2, 0, 0, 127, 121}; pg8::StaticOrder S; S.init(NTOK, 2 * FF, G, bxl);
            pg8::EpiSwiglu E{H8, sq0, (LAS const float*)(L + pg8::RS_TAB_OFF)}; pg8::gemm_phase<pg8::EpiSwiglu, true>(L, g, S, E, wv);
        }
        SEAM_L(pb + 1);
        if (EN(3) && IN(pb + 2)) { DEFPTRS; LAYERPTRS;
            pg8::Gemm g{(const bf16_t*)H8, W + WO_FA2, NTOK, DM, FF / 2, FF / 2, FF / 2, 0, 0, 124, 120}; pg8::StaticOrder S; S.init(NTOK, DM, G, bxl, 1);
            pg8::EpiResid E{XBA, XB, sq1, 0.5f, X8, (LAS unsigned char*)(L + pg8::STG_OFF)}; pg8::gemm_phase<pg8::EpiResid, true>(L, g, S, E, wv);
        }
        SEAM(pb + 2);
        if (EN(4) && IN(pb + 3)) { DEFPTRS; LAYERPTRS;
            pg8::Gemm g{(const bf16_t*)X8, W + WO_MIX, NTOK, NMIX, DM / 2, DM / 2, DM / 2, 0, 0, 127, 121}; pg8::StaticOrder S; S.init(NTOK, NMIX, G, bxl);
            pg8::EpiMix E{MIX, sq1, sqq, sqkv, KR, LF, ROPEC, ROPES, ka->in[3] + layer * 4, K2P, (LAS const float*)(L + pg8::RS_TAB_OFF)}; pg8::gemm_phase<pg8::EpiMix, true>(L, g, S, E, wv);
        }
        SEAM_L(pb + 3);
        if (EN(5) && IN(pb + 4)) { DEFPTRS; LAYERPTRS;
            if (EN(16) && wave == 0) for (int sg = vcu; sg < 256; sg += G) {
                const int bh = sg >> 3, seg = sg & 7, b = bh >> 2, h = bh & 3; float carry = 0.f, kmax = 0.f;
                { float a0 = 0.f, a1 = 0.f, m0 = 0.f, m1 = 0.f;
                  for (int i0 = 0; i0 < seg * 1024; i0 += 1024) {
                      float lf[16]; f32x2 kq[16];
#pragma unroll
                      for (int q = 0; q < 16; ++q) { const size_t r = (size_t)b * SEQ + i0 + 64 * q + lane; lf[q] = LF[r * 4 + h]; kq[q] = *(const f32x2*)(K2P + r * 8 + 2 * h); }
#pragma unroll
                      for (int q = 0; q < 16; q += 2) { a0 += lf[q]; a1 += lf[q + 1]; m0 = fmaxf(m0, kq[q][0] + kq[q][1]); m1 = fmaxf(m1, kq[q + 1][0] + kq[q + 1][1]); } }
                  carry = wave_sum(a0 + a1); kmax = fmaxf(m0, m1);
                  kmax = wave_max(kmax); }
                float lfc[16]; f32x2 kkc[16];
#pragma unroll
                for (int q = 0; q < 16; ++q) { const size_t row = (size_t)b * SEQ + 64 * (seg * 16 + q) + lane; lfc[q] = LF[row * 4 + h]; kkc[q] = *(const f32x2*)(K2P + row * 8 + 2 * h); }
#pragma unroll
                for (int q = 0; q < 16; ++q) { const int c = seg * 16 + q; float v = lfc[q];
                    v += __uint_as_float((unsigned)__builtin_amdgcn_update_dpp(0, (int)__float_as_uint(v), 0x111, 0xf, 0xf, true)); v += __uint_as_float((unsigned)__builtin_amdgcn_update_dpp(0, (int)__float_as_uint(v), 0x112, 0xf, 0xf, true));
                    v += __uint_as_float((unsigned)__builtin_amdgcn_update_dpp(0, (int)__float_as_uint(v), 0x114, 0xf, 0xf, true)); v += __uint_as_float((unsigned)__builtin_amdgcn_update_dpp(0, (int)__float_as_uint(v), 0x118, 0xf, 0xf, true));
                    v += __uint_as_float((unsigned)__builtin_amdgcn_update_dpp(0, (int)__float_as_uint(v), 0x142, 0xa, 0xf, false)); v += __uint_as_float((unsigned)__builtin_amdgcn_update_dpp(0, (int)__float_as_uint(v), 0x143, 0xc, 0xf, false));
                    v += carry; const float cref = __uint_as_float((unsigned)__builtin_amdgcn_readlane((int)__float_as_uint(v), 63)); carry = cref;
                    const float bias = (cref - v) * LOG2E; const unsigned hb = cvt_pk_bf16(bias, 0.f) & 0xffffu; const float hf = __uint_as_float(hb << 16); const unsigned lb = cvt_pk_bf16(bias - hf, 0.f) & 0xffffu;
                    *(u32x4*)(KX + ((size_t)bh * SEQ + 64 * c + lane) * 8) = (u32x4){hb | (lb << 16), 0u, 0u, 0u};
                    float k2 = kkc[q][0] + kkc[q][1];
                    k2 = wave_max(k2);
                    kmax = fmaxf(kmax, k2);
                    if (lane == 0) { TBA[bh * 128 + c] = -cref * LOG2E; KMXA[bh * 128 + c] = sqrtf(kmax) * 1.0001f; } }
            }
            if (EN(17)) { pg8::Gemm g{MIX + MX_MCQ, W + WO_UQ, NTOK, 1024, 256, NMIX, 256, 1, MX_T4 - MX_MCQ, 0, 0}; pg8::StaticOrder S; S.init(NTOK, 1024, G, bxl, 1);
              pg8::EpiQKVup E{{QM, sqq, ROPEC, ROPES}, {KN, VM, sqkv}}; pg8::gemm_phase(L, g, S, E, wv); }
            if (EN(19)) { hg::Args HA{MIX, ka->in[8], ka->in[9] + layer * 256, SLOC, LSEG, YS, layer};
              if (G == 256) { for (int i = 0; i < 4; ++i) hg::stage1_unit(L, HA, 4 * (vcu >> 5) + i, vcu & 31, wv); }
              else for (int u = vcu; u < 1024; u += G) hg::stage1_unit(L, HA, u >> 5, u & 31, wv); }
        }
        SEAM_L(pb + 4);
        if (EN(6) && IN(pb + 5)) { DEFPTRS; LAYERPTRS;
#define UNIT_OF(idx, bh, qb) const int quarter_ = (idx) >> 8, rem_ = (idx) & 255, s_ = rem_ & 7; const int g_ = rem_ >> 3; const int bh = (g_ & ~3) | ((g_ + quarter_) & 3), qb = quarter_ == 0 ? s_ : quarter_ == 1 ? 15 - s_ : quarter_ == 2 ? 16 + s_ : 31 - s_;
            if (EN(20)) { const att::Args A{MIX + MX_FQ, NMIX, 64, MIX + MX_FK, NMIX, KX, MIX + MX_FV, NMIX, TBA, KMXA, YS + 0};
              { bool pre = false;
                for (int idx = vcu; idx < 1024; idx += G) { UNIT_OF(idx, bh, qb); const bool hn = idx + G < 1024; int nbh = 0, nqb = 0; if (hn) { UNIT_OF(idx + G, bh2, qb2); nbh = bh2; nqb = qb2; }
                    att::attn_unit<att::FOX>((char*)lds, bh >> 2, bh & 3, qb, A, wv, pre, hn, nbh >> 2, nbh & 3, nqb); pre = hn; } } }
            if (EN(21)) { const att::Args A{QM, 384, 96, KN, 256, KR, VM, 256, nullptr, nullptr, YS + 256};
              { bool pre = false;
                for (int idx = vcu; idx < 1024; idx += G) { UNIT_OF(idx, bh, qb); const bool hn = idx + G < 1024; int nbh = 0, nqb = 0; if (hn) { UNIT_OF(idx + G, bh2, qb2); nbh = bh2; nqb = qb2; }
                    att::attn_unit<att::MLA>((char*)lds, bh >> 2, bh & 3, qb, A, wv, pre, hn, nbh >> 2, nbh & 3, nqb); pre = hn; } } }
            if (EN(22)) { const att::Args A{MIX + MX_SQ, NMIX, 64, MIX + MX_SK, NMIX, nullptr, MIX + MX_SV, NMIX, nullptr, nullptr, YS + 512};
              { bool pre = false;
                for (int idx = vcu; idx < 1024; idx += G) { UNIT_OF(idx, bh, qb); const bool hn = idx + G < 1024; int nbh = 0, nqb = 0; if (hn) { UNIT_OF(idx + G, bh2, qb2); nbh = bh2; nqb = qb2; }
                    att::attn_unit<att::SB>((char*)lds, bh >> 2, bh & 3, qb, A, wv, pre, hn, nbh >> 2, nbh & 3, nqb); pre = hn; } } }
            if (EN(23)) { hg::Args HA{MIX, ka->in[8], ka->in[9] + layer * 256, SLOC, LSEG, YS, layer};
              if (G == 256) { for (int i = 0; i < 4; ++i) hg::stage2_unit(L, HA, 4 * (vcu >> 5) + i, vcu & 31, wv); }
              else for (int u = vcu; u < 1024; u += G) hg::stage2_unit(L, HA, u >> 5, u & 31, wv); }
#undef UNIT_OF
        }
        SEAM(pb + 5);
        if (EN(7) && IN(pb + 6)) { DEFPTRS; LAYERPTRS;
            pg8::Gemm g{YS, W + WO_BR, NTOK, NGATE, 256, DM, 256, 2, 256, 0, 0}; pg8::StaticOrder S; S.init(NTOK, NGATE, G, bxl);
            pg8::EpiPnat E{(unsigned*)PBUF}; pg8::gemm_phase(L, g, S, E, wv);
        }
        SEAM_L(pb + 6);
        if (EN(8) && IN(pb + 7)) { DEFPTRS; LAYERPTRS;
            pg8::Gemm g{(const bf16_t*)X8, W + WO_GATE, NTOK, NGATE, DM / 2, DM / 2, DM / 2, 0, 0, 127, 121}; pg8::StaticOrder S; S.init(NTOK, NGATE, G, bxl, 1);
            pg8::EpiGate E{(unsigned char*)YS, (const unsigned*)PBUF, sq1, (LAS const float*)(L + pg8::RS_TAB_OFF)}; pg8::gemm_phase<pg8::EpiGate, true>(L, g, S, E, wv);
        }
        SEAM(pb + 7);
        if (EN(9) && IN(pb + 8)) { DEFPTRS; LAYERPTRS;
            pg8::Gemm g{YS, W + WO_OUT, NTOK, DM, DM / 2, DM / 2, DM / 2, 0, 0, 124, 121}; pg8::StaticOrder S; S.init(NTOK, DM, G, bxl);
            pg8::EpiResid E{XB, XB, sq2, 1.0f, X8, (LAS unsigned char*)(L + pg8::STG_OFF)}; pg8::gemm_phase<pg8::EpiResid, true>(L, g, S, E, wv);
        }
        SEAM_L(pb + 8);
        if (EN(10) && IN(pb + 9)) { DEFPTRS; LAYERPTRS;
            { pg8::Gemm g{(const bf16_t*)X8, W + WO_FB1, NTOK, 2 * FF, DM / 2, DM / 2, DM / 2, 0, 0, 127, 121}; pg8::StaticOrder S; S.init(NTOK, 2 * FF, G, bxl, 1);
              pg8::EpiSwiglu E{H8, sq2, (LAS const float*)(L + pg8::RS_TAB_OFF)}; pg8::gemm_phase<pg8::EpiSwiglu, true>(L, g, S, E, wv); }
            { pg8::Gemm g{PB, W + WO_PE, NTOK, DM, PLE, PLE, PLE, 0, 0, 0, 0}; pg8::StaticOrder S; S.init(NTOK, DM, G, bxl, 1);
              pg8::EpiBf16<DM> E{YS}; pg8::gemm_phase(L, g, S, E, wv); }
        }
        SEAM_L(pb + 9);
        if (EN(11) && IN(pb + 10)) { DEFPTRS; LAYERPTRS;
            pg8::Gemm g{(const bf16_t*)H8, W + WO_FB2, NTOK, DM, FF / 2, FF / 2, FF / 2, 0, 0, 124, 120}; pg8::StaticOrder S; S.init(NTOK, DM, G, bxl);
            pg8::EpiResid E{XB, XB, sq3, 0.5f, X8B, (LAS unsigned char*)(L + pg8::STG_OFF)}; pg8::gemm_phase<pg8::EpiResid, true>(L, g, S, E, wv);
        }
        SEAM_L(pb + 10);
        if (EN(12) && IN(pb + 11)) { DEFPTRS; LAYERPTRS;
            pg8::Gemm g{(const bf16_t*)X8B, W + WO_PG, NTOK, DM, DM / 2, DM / 2, DM / 2, 0, 0, 127, 121}; pg8::StaticOrder S; S.init(NTOK, DM, G, bxl, 1);
            pg8::EpiPle E{XB, XBA, YS, sq3, sq4, X8, (LAS const float*)(L + pg8::RS_TAB_OFF), (LAS unsigned char*)(L + pg8::STG_OFF)}; pg8::gemm_phase<pg8::EpiPle, true>(L, g, S, E, wv);
        }
        SEAM(pb + 11);
    }
    if (EN(13) && IN(49)) { DEFPTRS;
        const float* fn = ka->in[19]; const float* sqf = SQ;
        f32x4 gq[4];
#pragma unroll
        for (int j = 0; j < 4; ++j) gq[j] = ((const f32x4*)fn + lane)[64 * j];
        for (int row = gw; row < NTOK; row += 4 * NGW) {
            float rs[4]; u32x2 w[4][4];
#pragma unroll
            for (int q = 0; q < 4; ++q) { rs[q] = rstd16(sqf, row + q * NGW); const u32x2* xs = (const u32x2*)(XBA + (size_t)(row + q * NGW) * DM) + lane;
#pragma unroll
                for (int j = 0; j < 4; ++j) w[q][j] = xs[64 * j]; }
#pragma unroll
            for (int q = 0; q < 4; ++q) { f32x4* xr = (f32x4*)(X + (size_t)(row + q * NGW) * DM) + lane;
#pragma unroll
                for (int j = 0; j < 4; ++j) { const f32x4 v = {bf_lo(w[q][j].x), bf_hi(w[q][j].x), bf_lo(w[q][j].y), bf_hi(w[q][j].y)}; xr[64 * j] = v * rs[q] * gq[j]; } }
        }
    }
#undef IN
#undef SEAM
#undef SEAM_L
}

extern "C" void kernel_launch(void* const* d_in, const int* in_sizes, int n_in, void* d_out, int out_size, void* d_ws, size_t ws_size, hipStream_t stream) {
    static int grid = 0;
    if (grid == 0) {
        if (n_in != 20 || out_size != NTOK * DM || ws_size < WS_END) { fprintf(stderr, "kernel_launch: unexpected shapes (n_in %d, out %d, ws %zu)\n", n_in, out_size, ws_size); grid = -1; return; }
        int dev = 0, cus = 0, per_cu = 0;
        if (hipGetDevice(&dev) != hipSuccess || hipDeviceGetAttribute(&cus, hipDeviceAttributeMultiprocessorCount, dev) != hipSuccess) { grid = -1; return; }
        if (hipFuncSetAttribute((const void*)fwd, hipFuncAttributeMaxDynamicSharedMemorySize, LDS_BYTES) != hipSuccess) { fprintf(stderr, "kernel_launch: hipFuncSetAttribute failed\n"); grid = -1; return; }
        if (hipOccupancyMaxActiveBlocksPerMultiprocessor(&per_cu, (const void*)fwd, NWAVES * 64, LDS_BYTES) != hipSuccess || per_cu < 1) { fprintf(stderr, "kernel_launch: occupancy query says %d\n", per_cu); }
        (void)hipGetLastError();
        grid = cus;
    }
    if (grid < 0) return;
    if (hipMemsetAsync((char*)d_ws + WS_CTL, 0, CTL_ZERO_BYTES, stream) != hipSuccess) return;
    KArgs a{};
    for (int i = 0; i < 20; ++i) a.in[i] = (const float*)d_in[i];
    a.out = (float*)d_out; a.ws = (unsigned char*)d_ws; a.pad = 0;
#if MK_PER_PHASE
    for (int ph = 0; ph < N_PHASES; ++ph) { a.ph_lo = ph; a.ph_hi = ph + 1; a.li = ph; hipLaunchKernelGGL(fwd, dim3(grid), dim3(NWAVES * 64), LDS_BYTES, stream, a); }
#else
    a.ph_lo = 0; a.ph_hi = N_PHASES; a.li = 0;
    hipLaunchKernelGGL(fwd, dim3(grid), dim3(NWAVES * 64), LDS_BYTES, stream, a);
#endif
}
```
